# Optimizing an MI355X kernel written in HIP

```python
import jax, jax.numpy as jnp
from jax import lax
import numpy as np

D_MODEL = 1024
BATCH = 4
SEQ = 4096
DEPTH = 2
DEC_BATCH = 32
DEC_SEQ = 16
PAST_LEN = 1024

CHUNK = 64
N_META = 16
D_POOL = 256
POOL_WINDOWS = (2, 4, 8, 16)
N_POOL_GROUPS = 4
POOL_GROUP = D_POOL // N_POOL_GROUPS
POOL_STATE = 15
D_CONV = 256
CONV_W = 3
N_HEADS = 8
HEAD_DIM = 64
D_ATTN = N_HEADS * HEAD_DIM
Q_BLOCK = 128
N_BRANCH = 3
D_FF = 2816
RMS_EPS = 1e-6
IN_COLS = D_POOL + 3 * D_CONV + 3 * D_ATTN + N_BRANCH * D_MODEL

kernel_name = "hybrid_pool_conv_stickbreak_streaming_step"


def rmsnorm(x, g):
    xf = x.astype(jnp.float32)
    y = xf * lax.rsqrt(jnp.mean(xf * xf, axis=-1, keepdims=True) + RMS_EPS)
    return (y * g.astype(jnp.float32)).astype(x.dtype)


def swiglu(x, w_gate, w_up, w_down):
    return (jax.nn.silu(x @ w_gate) * (x @ w_up)) @ w_down


def pool_mix(a, prev, pos0, w_group, scale):
    bsz, t, _ = a.shape
    ext = jnp.concatenate([prev, a], axis=1)
    c = jnp.cumsum(ext.astype(jnp.float32), axis=1)
    c = jnp.pad(c, ((0, 0), (1, 0), (0, 0)))
    cur = c[:, POOL_STATE + 1:]
    pos = pos0 + jnp.arange(t)
    means = []
    for g, w in enumerate(POOL_WINDOWS):
        sl = slice(g * POOL_GROUP, (g + 1) * POOL_GROUP)
        s = cur[..., sl] - c[:, POOL_STATE + 1 - w:POOL_STATE + 1 - w + t, sl]
        cnt = jnp.minimum(pos + 1, w).astype(jnp.float32)[None, :, None]
        means.append(s / cnt)
    p = (jnp.concatenate(means, axis=-1) - a.astype(jnp.float32)).astype(a.dtype)
    p = p.reshape(bsz, t, N_POOL_GROUPS, POOL_GROUP)
    p = jnp.einsum('btgc,gcd->btgd', p, w_group).reshape(bsz, t, D_POOL) * scale
    return p, ext[:, -POOL_STATE:]


def conv_mix(xb, gate_b, gate_c, prev, conv_w):
    t = xb.shape[1]
    ext = jnp.concatenate([prev, gate_c * xb], axis=1)
    y = ext[:, 0:t] * conv_w[0]
    for j in range(1, CONV_W):
        y = y + ext[:, j:j + t] * conv_w[j]
    return gate_b * y, ext[:, -(CONV_W - 1):]


def stick_breaking(q, k, v, q_pos0):
    tq, tk = q.shape[1], k.shape[1]
    outs = []
    for qs in range(0, tq, Q_BLOCK):
        qe = min(qs + Q_BLOCK, tq)
        n_keys = max(1, min(tk, q_pos0 + qe - 1))
        z = jnp.einsum('bqhd,bkhd->bhqk', q[:, qs:qe].astype(jnp.float32),
                       k[:, :n_keys].astype(jnp.float32)) * (HEAD_DIM ** -0.5)
        tpos = q_pos0 + jnp.arange(qs, qe)
        spos = jnp.arange(n_keys)
        causal = spos[None, :] < tpos[:, None]
        log_keep = jnp.where(causal, jax.nn.log_sigmoid(-z), 0.0)
        later = lax.cumsum(log_keep, axis=3, reverse=True) - log_keep
        a = jnp.where(causal, jnp.exp(jax.nn.log_sigmoid(z) + later), 0.0)
        o = jnp.einsum('bhqk,bkhd->bqhd', a, v[:, :n_keys].astype(jnp.float32))
        outs.append(o.astype(q.dtype))
    return jnp.concatenate(outs, axis=1)


def trunk_layer(x, pool_prev, conv_prev, k_past, v_past, w):
    (n1, f1g, f1u, f1d, nm, w_in, pool_w, pool_s, pool_proj, conv_w, conv_proj,
     qn, kn, attn_proj, w_out, n2, f2g, f2u, f2d) = w
    bsz, t, _ = x.shape
    pos0 = k_past.shape[1]
    h = x + 0.5 * swiglu(rmsnorm(x, n1), f1g, f1u, f1d)
    u = rmsnorm(h, nm)
    proj = u @ w_in
    cuts = np.cumsum([D_POOL, D_CONV, D_CONV, D_CONV, D_ATTN, D_ATTN, D_ATTN]).tolist()
    a_in, xb, gb, gc, q, k, v, g_logits = jnp.split(proj, cuts, axis=-1)
    y_a, pool_state = pool_mix(a_in, pool_prev, pos0, pool_w, pool_s)
    y_a = y_a @ pool_proj
    y_b, conv_state = conv_mix(xb, gb, gc, conv_prev, conv_w)
    y_b = y_b @ conv_proj
    q = rmsnorm(q.reshape(bsz, t, N_HEADS, HEAD_DIM), qn)
    k = rmsnorm(k.reshape(bsz, t, N_HEADS, HEAD_DIM), kn)
    v = v.reshape(bsz, t, N_HEADS, HEAD_DIM)
    k_all = jnp.concatenate([k_past, k], axis=1)
    v_all = jnp.concatenate([v_past, v], axis=1)
    o = stick_breaking(q, k_all, v_all, pos0)
    y_c = o.reshape(bsz, t, D_ATTN) @ attn_proj
    g = jax.nn.sigmoid(g_logits.astype(jnp.float32)).astype(x.dtype).reshape(bsz, t, N_BRANCH, D_MODEL)
    mixed = g[:, :, 0] * y_a + g[:, :, 1] * y_b + g[:, :, 2] * y_c
    h = h + mixed @ w_out
    h = h + 0.5 * swiglu(rmsnorm(h, n2), f2g, f2u, f2d)
    return h, k, v, pool_state, conv_state


def setup_inputs(seed: int = 0) -> dict:
    key = jax.random.key(seed)
    ks = jax.random.split(key, 32)
    f32 = jnp.float32

    def nrm(k, shape, scale):
        return jax.random.normal(k, shape, f32) * scale

    def gain(k, shape):
        return 1.0 + 0.05 * jax.random.normal(k, shape, f32)

    return {
        "x_prompt": nrm(ks[0], (BATCH, SEQ, D_MODEL), 1.0),
        "x_sample": nrm(ks[1], (DEC_BATCH, DEC_SEQ, D_MODEL), 1.0),
        "cache_k": nrm(ks[2], (DEPTH, DEC_BATCH, PAST_LEN, N_HEADS, HEAD_DIM), 1.0),
        "cache_v": nrm(ks[3], (DEPTH, DEC_BATCH, PAST_LEN, N_HEADS, HEAD_DIM), 1.0),
        "state_pool": nrm(ks[4], (DEPTH, DEC_BATCH, POOL_STATE, D_POOL), 1.0),
        "state_conv": nrm(ks[5], (DEPTH, DEC_BATCH, CONV_W - 1, D_CONV), 1.0),
        "meta": nrm(ks[6], (N_META, D_MODEL), 1.0),
        "ffn1_norm": gain(ks[7], (DEPTH, D_MODEL)),
        "ffn1_w_gate": nrm(ks[8], (DEPTH, D_MODEL, D_FF), D_MODEL ** -0.5),
        "ffn1_w_up": nrm(ks[9], (DEPTH, D_MODEL, D_FF), D_MODEL ** -0.5),
        "ffn1_w_down": nrm(ks[10], (DEPTH, D_FF, D_MODEL), D_FF ** -0.5),
        "mix_norm": gain(ks[11], (DEPTH, D_MODEL)),
        "w_in": nrm(ks[12], (DEPTH, D_MODEL, IN_COLS), D_MODEL ** -0.5),
        "pool_w": nrm(ks[13], (DEPTH, N_POOL_GROUPS, POOL_GROUP, POOL_GROUP), POOL_GROUP ** -0.5),
        "pool_scale": gain(ks[14], (DEPTH, D_POOL)),
        "pool_proj": nrm(ks[15], (DEPTH, D_POOL, D_MODEL), D_POOL ** -0.5),
        "conv_w": nrm(ks[16], (DEPTH, CONV_W, D_CONV), CONV_W ** -0.5),
        "conv_proj": nrm(ks[17], (DEPTH, D_CONV, D_MODEL), D_CONV ** -0.5),
        "q_norm": gain(ks[18], (DEPTH, N_HEADS, HEAD_DIM)),
        "k_norm": gain(ks[19], (DEPTH, N_HEADS, HEAD_DIM)),
        "attn_proj": nrm(ks[20], (DEPTH, D_ATTN, D_MODEL), D_ATTN ** -0.5),
        "w_out": nrm(ks[21], (DEPTH, D_MODEL, D_MODEL), D_MODEL ** -0.5),
        "ffn2_norm": gain(ks[22], (DEPTH, D_MODEL)),
        "ffn2_w_gate": nrm(ks[23], (DEPTH, D_MODEL, D_FF), D_MODEL ** -0.5),
        "ffn2_w_up": nrm(ks[24], (DEPTH, D_MODEL, D_FF), D_MODEL ** -0.5),
        "ffn2_w_down": nrm(ks[25], (DEPTH, D_FF, D_MODEL), D_FF ** -0.5),
    }


def reference(x_prompt, x_sample, cache_k, cache_v, state_pool, state_conv, meta,
              ffn1_norm, ffn1_w_gate, ffn1_w_up, ffn1_w_down, mix_norm, w_in,
              pool_w, pool_scale, pool_proj, conv_w, conv_proj, q_norm, k_norm,
              attn_proj, w_out, ffn2_norm, ffn2_w_gate, ffn2_w_up, ffn2_w_down):
    bsz = x_prompt.shape[0]
    dt = x_prompt.dtype
    meta_b = jnp.broadcast_to(meta[None].astype(dt), (bsz, N_META, D_MODEL))
    hp = jnp.concatenate([meta_b, x_prompt], axis=1)
    hs = x_sample
    zero_pool = jnp.zeros((bsz, POOL_STATE, D_POOL), dt)
    zero_conv = jnp.zeros((bsz, CONV_W - 1, D_CONV), dt)
    zero_kv = jnp.zeros((bsz, 0, N_HEADS, HEAD_DIM), dt)
    kp, vp, pp, cp, ks_, vs_, ps_, cs_ = [], [], [], [], [], [], [], []
    for l in range(DEPTH):
        w = (ffn1_norm[l], ffn1_w_gate[l], ffn1_w_up[l], ffn1_w_down[l], mix_norm[l], w_in[l],
             pool_w[l], pool_scale[l], pool_proj[l], conv_w[l], conv_proj[l],
             q_norm[l], k_norm[l], attn_proj[l], w_out[l],
             ffn2_norm[l], ffn2_w_gate[l], ffn2_w_up[l], ffn2_w_down[l])
        hp, k_new, v_new, pool_new, conv_new = trunk_layer(hp, zero_pool, zero_conv, zero_kv, zero_kv, w)
        kp.append(k_new); vp.append(v_new); pp.append(pool_new); cp.append(conv_new)
        hs, k_new, v_new, pool_new, conv_new = trunk_layer(
            hs, state_pool[l], state_conv[l], cache_k[l], cache_v[l], w)
        ks_.append(k_new); vs_.append(v_new); ps_.append(pool_new); cs_.append(conv_new)
    y_prompt = hp[:, N_META:]
    return (y_prompt, hs, jnp.stack(kp), jnp.stack(vp), jnp.stack(pp), jnp.stack(cp),
            jnp.stack(ks_), jnp.stack(vs_), jnp.stack(ps_), jnp.stack(cs_))
```

```cpp
#include <hip/hip_runtime.h>
#include <hip/hip_cooperative_groups.h>
#include <cstdio>
#include <cstdint>
namespace cg = cooperative_groups;

#ifndef REP_PH
#define REP_PH -1
#endif
#ifndef REP_SUB
#define REP_SUB 7
#endif
#ifndef PERM_MASK
#define PERM_MASK 8
#endif
#ifndef MK_ONE_LAUNCH
#define MK_ONE_LAUNCH 1
#endif

#define LAS __attribute__((address_space(3)))
typedef unsigned short bf16_t;
typedef short bf16x8 __attribute__((ext_vector_type(8)));
typedef short s16x4 __attribute__((ext_vector_type(4)));
typedef float f32x4 __attribute__((ext_vector_type(4)));
typedef float f32x16 __attribute__((ext_vector_type(16)));
typedef unsigned u32x4 __attribute__((ext_vector_type(4)));
typedef unsigned u32x2 __attribute__((ext_vector_type(2)));

constexpr int DM = 1024, TP = 4112, NPR = 4 * TP, NSR = 512, MR = NPR + NSR, MP = 17152, DFF = 2816, NIN = 5632;
constexpr int LDV = 4160;
constexpr float RMS_EPS = 1e-6f;
constexpr float QSCALE = 0.125f * 1.4426950408889634f;
constexpr size_t OFF_YP = 0;
constexpr size_t OFF_YS = OFF_YP + (size_t)4 * 4096 * 1024;
constexpr size_t OFF_KP = OFF_YS + (size_t)512 * 1024;
constexpr size_t OFF_VP = OFF_KP + (size_t)2 * NPR * 512;
constexpr size_t OFF_PP = OFF_VP + (size_t)2 * NPR * 512;
constexpr size_t OFF_CP = OFF_PP + (size_t)2 * 4 * 15 * 256;
constexpr size_t OFF_KS = OFF_CP + (size_t)2 * 4 * 2 * 256;
constexpr size_t OFF_VS = OFF_KS + (size_t)2 * 512 * 512;
constexpr size_t OFF_PS = OFF_VS + (size_t)2 * 512 * 512;
constexpr size_t OFF_CS = OFF_PS + (size_t)2 * 32 * 15 * 256;
constexpr size_t OUT_TOTAL = OFF_CS + (size_t)2 * 32 * 2 * 256;
constexpr size_t MiB = 1u << 20;
constexpr size_t WS_RSS = 0;
constexpr size_t WS_BAR = 768 * 1024;
constexpr size_t WS_W = 1 * MiB;
constexpr size_t W_GU1 = 0, W_DN1 = W_GU1 + (size_t)NIN * DM * 2, W_IN = W_DN1 + (size_t)DM * DFF * 2, W_BR = W_IN + (size_t)NIN * DM * 2,
                 W_OUT = W_BR + (size_t)DM * DM * 2, W_GU2 = W_OUT + (size_t)DM * DM * 2, W_DN2 = W_GU2 + (size_t)NIN * DM * 2, W_LAYER = W_DN2 + (size_t)DM * DFF * 2;
static_assert(W_LAYER == 48 * MiB, "weights per layer");
constexpr size_t WS_XB = 97 * MiB;
constexpr size_t WS_HF = 131 * MiB;
constexpr size_t WS_ACT = 198 * MiB;
constexpr size_t WS_G = 198 * MiB;
constexpr size_t WS_PA = 299 * MiB;
constexpr size_t WS_MIXF = 299 * MiB;
constexpr size_t WS_MIXB = 366 * MiB;
constexpr size_t WS_Q = 366 * MiB;
constexpr size_t WS_KP = 383 * MiB;
constexpr size_t WS_VT = 400 * MiB;
constexpr size_t WS_PRE = 421 * MiB;
constexpr size_t WS_END = 455 * MiB;
static_assert(WS_XB + (size_t)MP * DM * 2 <= WS_HF && WS_HF + (size_t)MP * DM * 4 <= WS_ACT && WS_G + (size_t)MP * 3072 * 2 <= WS_PA && WS_PA + (size_t)MP * DM * 4 <= WS_Q &&
              WS_Q + (size_t)MP * 512 * 2 <= WS_KP && WS_KP + (size_t)(48 + MP) * 1024 <= WS_VT && WS_VT + (size_t)40 * 64 * LDV * 2 <= WS_PRE && WS_PRE + (size_t)MP * DM * 2 <= WS_END, "ws map");
constexpr int LDS_CTL = 8 * 16640;
constexpr int LDS_BYTES = LDS_CTL + 64;

struct Args { const float* in[26]; float* out; unsigned char* ws; int ph_lo, ph_hi; };

struct Ctx {
    const float* const* in;
    float* out; unsigned char* ws;
    float* RSS; bf16_t* XB; float* HF; bf16_t* ACT; bf16_t* G; float* PA; float* MIXF; bf16_t* PAB; bf16_t* MIXB; bf16_t* Q; bf16_t* KP; bf16_t* VT; bf16_t* VB; bf16_t* PRE;
};

__device__ __forceinline__ unsigned cvt_pk_bf16(float lo, float hi) { unsigned r; asm volatile("v_cvt_pk_bf16_f32 %0, %1, %2" : "=v"(r) : "v"(lo), "v"(hi)); return r; }
__device__ __forceinline__ u32x2 pk4(f32x4 v) { u32x2 r; r.x = cvt_pk_bf16(v[0], v[1]); r.y = cvt_pk_bf16(v[2], v[3]); return r; }
__device__ __forceinline__ float bf2f(unsigned short b) { return __uint_as_float(((unsigned)b) << 16); }
__device__ __forceinline__ f32x4 unpk4(u32x2 p) { f32x4 r; r[0] = __uint_as_float(p.x << 16); r[1] = __uint_as_float(p.x & 0xffff0000u); r[2] = __uint_as_float(p.y << 16); r[3] = __uint_as_float(p.y & 0xffff0000u); return r; }
__device__ __forceinline__ int opaque_tid() { int t = threadIdx.x; asm volatile("" : "+v"(t)); return t; }
__device__ __forceinline__ int opaque_bid() { int t = blockIdx.x; asm volatile("" : "+s"(t)); return t; }
__device__ __forceinline__ int crow(int r, int hi) { return (r & 3) + 8 * (r >> 2) + 4 * hi; }

namespace pg8 {
constexpr int BM = 256, BK = 64, HALF = 128, HTB = HALF * BK * 2, STAGE_BYTES = 8 * HTB, NXCD = 8, WGM = 8;
__host__ __device__ __forceinline__ int lds_byte(int r, int c) { const int st = (r >> 4) * 2 + (c >> 5), rr = r & 15, cc = c & 31, ob = rr * 64 + cc * 2; return st * 1024 + (ob ^ (((ob >> 9) & 1) << 5)); }
__host__ __device__ __forceinline__ void stage_rc(int b, int& R, int& C) { const int st = b / 1024, sb = b % 1024, swz = sb ^ (((sb >> 9) & 1) << 5); R = (st >> 1) * 16 + swz / 64; C = (st & 1) * 32 + (swz % 64) / 2; }

struct Unit { int pm, pn, kofs, nt, seg; };
struct Gemm { const bf16_t* A; const bf16_t* Bt; int lda, ldb; };
struct Sched {
    int nM, nN, nwg, G, c, segs, nt_full;
    __device__ bool next(int i, Unit& u) const {
        const int ti = (segs == 3) ? i / 3 : i; const int sg = (segs == 3) ? i - 3 * ti : 3;
        const long L = (long)ti * G + c; if (L >= nwg) return false;
        int wgid = (int)L; { const int q = nwg / NXCD, r = nwg % NXCD, xcd = wgid % NXCD, off = wgid / NXCD; wgid = (xcd < r ? xcd * (q + 1) : r * (q + 1) + (xcd - r) * q) + off; }
        const int nig = WGM * nN, gid = wgid / nig, fm = gid * WGM, gsz = (nM - fm) < WGM ? (nM - fm) : WGM;
        u.pm = fm + ((wgid % nig) % gsz); u.pn = (wgid % nig) / gsz;
        u.seg = sg;
        if (segs == 3) { u.kofs = sg == 0 ? 0 : (sg == 1 ? 256 : 512); u.nt = sg == 2 ? 8 : 4; }
        else { u.kofs = 0; u.nt = nt_full; }
        return true;
    }
};
enum { EK_SWIGLU = 0, EK_RESID = 1, EK_PROJ = 2, EK_BRANCH = 3 };
struct EpiDesc { int kind, l, final_; float alpha; const float* rss_in; float* rss_out; };

__device__ __forceinline__ float sigmoidf_(float v) { return __builtin_amdgcn_rcpf(1.f + __builtin_amdgcn_exp2f(-1.4426950408889634f * v)); }

template <int K>
__device__ __forceinline__ void epilogue(const f32x4 (&acc)[2][2][4][2], const Unit& u, const EpiDesc& E, const Ctx& C, int wr, int wc, int fr, int fq) {
    const int row0 = u.pm * 256 + wr * 64 + fr;
    const int lc0 = 32 * wc + 4 * fq;
    if (K == EK_SWIGLU || K == EK_PROJ) {
        float rstd[2][4];
#pragma unroll
        for (int ai = 0; ai < 2; ++ai)
#pragma unroll
            for (int m = 0; m < 4; ++m) rstd[ai][m] = E.rss_in[row0 + 128 * ai + 16 * m];
#pragma unroll
        for (int ai = 0; ai < 2; ++ai)
#pragma unroll
            for (int m = 0; m < 4; ++m) rstd[ai][m] = __builtin_amdgcn_rsqf(rstd[ai][m] * (1.f / 1024.f) + RMS_EPS);
        if (K == EK_SWIGLU) {
#pragma unroll
            for (int ai = 0; ai < 2; ++ai)
#pragma unroll
                for (int m = 0; m < 4; ++m) {
                    const int row = row0 + 128 * ai + 16 * m;
#pragma unroll
                    for (int bj = 0; bj < 2; ++bj) {
                        const f32x4 g = acc[ai][bj][m][0] * rstd[ai][m], up = acc[ai][bj][m][1] * rstd[ai][m];
                        f32x4 a;
#pragma unroll
                        for (int i = 0; i < 4; ++i) a[i] = g[i] * sigmoidf_(g[i]) * up[i];
                        const int j = 16 * (8 * u.pn + 4 * bj + wc) + 4 * fq;
                        *(u32x2*)(C.ACT + (size_t)row * DFF + j) = pk4(a);
                    }
                }
        } else {
            const int pn = u.pn, l = E.l;
            if (pn < 4) {
#pragma unroll
                for (int ai = 0; ai < 2; ++ai)
#pragma unroll
                    for (int m = 0; m < 4; ++m) {
                        const int row = row0 + 128 * ai + 16 * m;
#pragma unroll
                        for (int bj = 0; bj < 2; ++bj)
#pragma unroll
                            for (int n = 0; n < 2; ++n) *(u32x2*)(C.PAB + (size_t)row * DM + 256 * pn + 128 * bj + 16 * n + lc0) = pk4(acc[ai][bj][m][n] * rstd[ai][m]);
                    }
            } else if (pn < 8) {
                const bool isk = pn >= 6; const int head = 4 * (pn & 1) + wc;
                const float* gn = C.in[isk ? 19 : 18] + (size_t)l * 512 + 64 * head + 4 * fq;
                f32x4 gv[2][2];
#pragma unroll
                for (int bj = 0; bj < 2; ++bj)
#pragma unroll
                    for (int n = 0; n < 2; ++n) gv[bj][n] = *(const f32x4*)(gn + 32 * bj + 16 * n) * (isk ? 1.f : QSCALE);
#pragma unroll
                for (int ai = 0; ai < 2; ++ai)
#pragma unroll
                    for (int m = 0; m < 4; ++m) {
                        const int row = row0 + 128 * ai + 16 * m;
                        f32x4 v[2][2]; float ss = 0.f;
#pragma unroll
                        for (int bj = 0; bj < 2; ++bj)
#pragma unroll
                            for (int n = 0; n < 2; ++n) { v[bj][n] = acc[ai][bj][m][n] * rstd[ai][m]; ss += v[bj][n][0] * v[bj][n][0] + v[bj][n][1] * v[bj][n][1] + v[bj][n][2] * v[bj][n][2] + v[bj][n][3] * v[bj][n][3]; }
                        ss += __shfl_xor(ss, 16); ss += __shfl_xor(ss, 32);
                        const float rinv = __builtin_amdgcn_rsqf(ss * (1.f / 64.f) + RMS_EPS);
                        float* kdst = (float*)(C.PRE + (size_t)row * DM);
                        if (row < NPR) kdst = C.out + OFF_KP + ((size_t)l * NPR + row) * 512; else if (row < MR) kdst = C.out + OFF_KS + ((size_t)l * NSR + (row - NPR)) * 512;
                        bf16_t* bdst = (isk ? C.KP : C.Q) + (size_t)row * 512 + 64 * head + 4 * fq;
#pragma unroll
                        for (int bj = 0; bj < 2; ++bj)
#pragma unroll
                            for (int n = 0; n < 2; ++n) {
                                const int d = 32 * bj + 16 * n;
                                const f32x4 o = v[bj][n] * rinv * gv[bj][n];
                                *(u32x2*)(bdst + d) = pk4(o);
                                if (isk) *(f32x4*)(kdst + 64 * head + 4 * fq + d) = o;
                            }
                    }
            } else if (pn < 10) {
#pragma unroll
                for (int ai = 0; ai < 2; ++ai)
#pragma unroll
                    for (int m = 0; m < 4; ++m) {
                        const int row = row0 + 128 * ai + 16 * m;
                        float* vdst = (float*)(C.PRE + (size_t)row * DM);
                        if (row < NPR) vdst = C.out + OFF_VP + ((size_t)l * NPR + row) * 512; else if (row < MR) vdst = C.out + OFF_VS + ((size_t)l * NSR + (row - NPR)) * 512;
#pragma unroll
                        for (int bj = 0; bj < 2; ++bj)
#pragma unroll
                            for (int n = 0; n < 2; ++n) {
                                const int c512 = 256 * (pn - 8) + 128 * bj + 16 * n + lc0;
                                const f32x4 o = acc[ai][bj][m][n] * rstd[ai][m];
                                *(f32x4*)(vdst + c512) = o;
                                *(u32x2*)(C.VB + (size_t)row * 512 + c512) = pk4(o);
                            }
                    }
            } else {
                const int br = (pn - 10) >> 2, cb = 256 * ((pn - 10) & 3);
#pragma unroll
                for (int ai = 0; ai < 2; ++ai)
#pragma unroll
                    for (int m = 0; m < 4; ++m) {
                        const int row = row0 + 128 * ai + 16 * m;
#pragma unroll
                        for (int bj = 0; bj < 2; ++bj)
#pragma unroll
                            for (int n = 0; n < 2; ++n) {
                                const f32x4 x = acc[ai][bj][m][n] * rstd[ai][m]; f32x4 sg;
#pragma unroll
                                for (int i = 0; i < 4; ++i) sg[i] = fmaxf(sigmoidf_(x[i]), 1e-30f);
                                *(u32x2*)(C.G + (size_t)row * 3072 + br * 1024 + cb + 128 * bj + 16 * n + lc0) = pk4(sg);
                            }
                    }
            }
        }
    } else if (K == EK_RESID) {
#pragma unroll
        for (int ai = 0; ai < 2; ++ai)
#pragma unroll
        for (int mh = 0; mh < 2; ++mh) {
            u32x2 h[2][2][2];
#pragma unroll
            for (int m2 = 0; m2 < 2; ++m2)
#pragma unroll
                for (int bj = 0; bj < 2; ++bj)
#pragma unroll
                    for (int n = 0; n < 2; ++n) h[m2][bj][n] = *(const u32x2*)(C.XB + (size_t)(row0 + 128 * ai + 16 * (2 * mh + m2)) * DM + 256 * u.pn + 128 * bj + 16 * n + lc0);
#pragma unroll
            for (int m2 = 0; m2 < 2; ++m2) {
                const int m = 2 * mh + m2;
                const int row = row0 + 128 * ai + 16 * m;
                float* dst = C.PA + (size_t)row * DM;
                if (E.final_) {
                    if (row < NPR) { const int b = row / TP, t = row - b * TP; if (t >= 16) dst = C.out + OFF_YP + ((size_t)b * 4096 + (t - 16)) * 1024; }
                    else if (row < MR) dst = C.out + OFF_YS + (size_t)(row - NPR) * 1024;
                }
                float ss = 0.f;
#pragma unroll
                for (int bj = 0; bj < 2; ++bj)
#pragma unroll
                    for (int n = 0; n < 2; ++n) {
                        const int col = 256 * u.pn + 128 * bj + 16 * n + lc0;
                        const f32x4 hv = unpk4(h[m2][bj][n]) + acc[ai][bj][m][n] * E.alpha;
                        if (E.final_) *(f32x4*)(dst + col) = hv;
                        else {
                            *(u32x2*)(C.XB + (size_t)row * DM + col) = pk4(hv);
                            ss += hv[0] * hv[0] + hv[1] * hv[1] + hv[2] * hv[2] + hv[3] * hv[3];
                        }
                    }
                if (!E.final_) {
                    ss += __shfl_xor(ss, 16); ss += __shfl_xor(ss, 32);
                    if (fq == 0) unsafeAtomicAdd(E.rss_out + row, ss);
                }
            }
        }
    } else {
        const int seg = u.seg;
#pragma unroll
        for (int ai = 0; ai < 2; ++ai)
#pragma unroll
        for (int mh = 0; mh < 2; ++mh) {
            u32x2 gq[2][2][2], mf[2][2][2];
#pragma unroll
            for (int m2 = 0; m2 < 2; ++m2)
#pragma unroll
                for (int bj = 0; bj < 2; ++bj)
#pragma unroll
                    for (int n = 0; n < 2; ++n) {
                        const int row = row0 + 128 * ai + 16 * (2 * mh + m2), col = 256 * u.pn + 128 * bj + 16 * n + lc0;
                        gq[m2][bj][n] = *(const u32x2*)(C.G + (size_t)row * 3072 + seg * 1024 + col);
                        if (seg > 0) mf[m2][bj][n] = *(const u32x2*)(C.MIXB + (size_t)row * DM + col); else mf[m2][bj][n] = (u32x2){0u, 0u};
                    }
#pragma unroll
            for (int m2 = 0; m2 < 2; ++m2)
#pragma unroll
                for (int bj = 0; bj < 2; ++bj)
#pragma unroll
                    for (int n = 0; n < 2; ++n) {
                        const int row = row0 + 128 * ai + 16 * (2 * mh + m2), col = 256 * u.pn + 128 * bj + 16 * n + lc0;
                        const f32x4 r = acc[ai][bj][2 * mh + m2][n] * unpk4(gq[m2][bj][n]) + unpk4(mf[m2][bj][n]);
                        *(u32x2*)(C.MIXB + (size_t)row * DM + col) = pk4(r);
                    }
        }
    }
}

__host__ __device__ __forceinline__ int perm32(int rho) { const int n = rho >> 4, i = rho & 15; return 8 * (i >> 2) + 4 * n + (i & 3); }
__device__ __forceinline__ u32x4 pk8(f32x4 a, f32x4 b) { const u32x2 p = pk4(a), q = pk4(b); return (u32x4){p.x, p.y, q.x, q.y}; }
template <int K>
__device__ __forceinline__ void epilogue_p(const f32x4 (&acc)[2][2][4][2], const Unit& u, const EpiDesc& E, const Ctx& C, int wr, int wc, int fr, int fq) {
    const int row0 = u.pm * 256 + wr * 64 + fr;
    const int lc8 = 32 * wc + 8 * fq;
    if (K == EK_SWIGLU || K == EK_PROJ) {
        float rstd[2][4];
#pragma unroll
        for (int ai = 0; ai < 2; ++ai)
#pragma unroll
            for (int m = 0; m < 4; ++m) rstd[ai][m] = E.rss_in[row0 + 128 * ai + 16 * m];
#pragma unroll
        for (int ai = 0; ai < 2; ++ai)
#pragma unroll
            for (int m = 0; m < 4; ++m) rstd[ai][m] = __builtin_amdgcn_rsqf(rstd[ai][m] * (1.f / 1024.f) + RMS_EPS);
        if (K == EK_SWIGLU) {
#pragma unroll
            for (int ai = 0; ai < 2; ++ai)
#pragma unroll
                for (int m = 0; m < 4; ++m) {
                    const int row = row0 + 128 * ai + 16 * m;
                    f32x4 a[2];
#pragma unroll
                    for (int n = 0; n < 2; ++n) {
                        const f32x4 g = acc[ai][0][m][n] * rstd[ai][m], up = acc[ai][1][m][n] * rstd[ai][m];
#pragma unroll
                        for (int i = 0; i < 4; ++i) a[n][i] = g[i] * sigmoidf_(g[i]) * up[i];
                    }
                    *(u32x4*)(C.ACT + (size_t)row * DFF + 128 * u.pn + lc8) = pk8(a[0], a[1]);
                }
        } else {
            const int pn = u.pn, l = E.l;
            if (pn < 4) {
#pragma unroll
                for (int ai = 0; ai < 2; ++ai)
#pragma unroll
                    for (int m = 0; m < 4; ++m) {
                        const int row = row0 + 128 * ai + 16 * m;
#pragma unroll
                        for (int bj = 0; bj < 2; ++bj) *(u32x4*)(C.PAB + (size_t)row * DM + 256 * pn + 128 * bj + lc8) = pk8(acc[ai][bj][m][0] * rstd[ai][m], acc[ai][bj][m][1] * rstd[ai][m]);
                    }
            } else if (pn < 8) {
                const bool isk = pn >= 6; const int head = 4 * (pn & 1) + wc;
                const float* gn = C.in[isk ? 19 : 18] + (size_t)l * 512 + 64 * head + 8 * fq;
                f32x4 gv[2][2];
#pragma unroll
                for (int bj = 0; bj < 2; ++bj)
#pragma unroll
                    for (int n = 0; n < 2; ++n) gv[bj][n] = *(const f32x4*)(gn + 32 * bj + 4 * n) * (isk ? 1.f : QSCALE);
#pragma unroll
                for (int ai = 0; ai < 2; ++ai)
#pragma unroll
                    for (int m = 0; m < 4; ++m) {
                        const int row = row0 + 128 * ai + 16 * m;
                        f32x4 v[2][2]; float ss = 0.f;
#pragma unroll
                        for (int bj = 0; bj < 2; ++bj)
#pragma unroll
                            for (int n = 0; n < 2; ++n) { v[bj][n] = acc[ai][bj][m][n] * rstd[ai][m]; ss += v[bj][n][0] * v[bj][n][0] + v[bj][n][1] * v[bj][n][1] + v[bj][n][2] * v[bj][n][2] + v[bj][n][3] * v[bj][n][3]; }
                        ss += __shfl_xor(ss, 16); ss += __shfl_xor(ss, 32);
                        const float rinv = __builtin_amdgcn_rsqf(ss * (1.f / 64.f) + RMS_EPS);
                        float* kdst = (float*)(C.PRE + (size_t)row * DM);
                        if (row < NPR) kdst = C.out + OFF_KP + ((size_t)l * NPR + row) * 512; else if (row < MR) kdst = C.out + OFF_KS + ((size_t)l * NSR + (row - NPR)) * 512;
                        bf16_t* bdst = (isk ? C.KP : C.Q) + (size_t)row * 512 + 64 * head + 8 * fq;
#pragma unroll
                        for (int bj = 0; bj < 2; ++bj) {
                            const f32x4 o0 = v[bj][0] * rinv * gv[bj][0], o1 = v[bj][1] * rinv * gv[bj][1];
                            *(u32x4*)(bdst + 32 * bj) = pk8(o0, o1);
                            if (isk) { *(f32x4*)(kdst + 64 * head + 8 * fq + 32 * bj) = o0; *(f32x4*)(kdst + 64 * head + 8 * fq + 32 * bj + 4) = o1; }
                        }
                    }
            } else if (pn < 10) {
#pragma unroll
                for (int ai = 0; ai < 2; ++ai)
#pragma unroll
                    for (int m = 0; m < 4; ++m) {
                        const int row = row0 + 128 * ai + 16 * m;
                        float* vdst = (float*)(C.PRE + (size_t)row * DM);
                        if (row < NPR) vdst = C.out + OFF_VP + ((size_t)l * NPR + row) * 512; else if (row < MR) vdst = C.out + OFF_VS + ((size_t)l * NSR + (row - NPR)) * 512;
                        const int b = row / TP, t = row - b * TP;
                        bf16_t* vt = C.VT + (size_t)b * 512 * LDV + 48 + t;
#pragma unroll
                        for (int bj = 0; bj < 2; ++bj)
#pragma unroll
                            for (int n = 0; n < 2; ++n) {
                                const int c512 = 256 * (pn - 8) + 128 * bj + lc8 + 4 * n;
                                const f32x4 o = acc[ai][bj][m][n] * rstd[ai][m];
                                *(f32x4*)(vdst + c512) = o;
                                const u32x2 p = pk4(o);
                                vt[(size_t)(c512 + 0) * LDV] = (bf16_t)(p.x & 0xffffu); vt[(size_t)(c512 + 1) * LDV] = (bf16_t)(p.x >> 16);
                                vt[(size_t)(c512 + 2) * LDV] = (bf16_t)(p.y & 0xffffu); vt[(size_t)(c512 + 3) * LDV] = (bf16_t)(p.y >> 16);
                            }
                    }
            } else {
                const int br = (pn - 10) >> 2, cb = 256 * ((pn - 10) & 3);
#pragma unroll
                for (int ai = 0; ai < 2; ++ai)
#pragma unroll
                    for (int m = 0; m < 4; ++m) {
                        const int row = row0 + 128 * ai + 16 * m;
#pragma unroll
                        for (int bj = 0; bj < 2; ++bj) {
                            f32x4 sg[2];
#pragma unroll
                            for (int n = 0; n < 2; ++n) {
                                const f32x4 x = acc[ai][bj][m][n] * rstd[ai][m];
#pragma unroll
                                for (int i = 0; i < 4; ++i) sg[n][i] = sigmoidf_(x[i]);
                            }
                            *(u32x4*)(C.G + (size_t)row * 3072 + br * 1024 + cb + 128 * bj + lc8) = pk8(sg[0], sg[1]);
                        }
                    }
            }
        }
    } else if (K == EK_RESID) {
#pragma unroll
        for (int ai = 0; ai < 2; ++ai)
#pragma unroll
        for (int mh = 0; mh < 2; ++mh) {
            u32x4 h[2][2];
#pragma unroll
            for (int m2 = 0; m2 < 2; ++m2)
#pragma unroll
                for (int bj = 0; bj < 2; ++bj) h[m2][bj] = *(const u32x4*)(C.XB + (size_t)(row0 + 128 * ai + 16 * (2 * mh + m2)) * DM + 256 * u.pn + 128 * bj + lc8);
#pragma unroll
            for (int m2 = 0; m2 < 2; ++m2) {
                const int m = 2 * mh + m2;
                const int row = row0 + 128 * ai + 16 * m;
                float* dst = C.PA + (size_t)row * DM;
                if (E.final_) {
                    if (row < NPR) { const int b = row / TP, t = row - b * TP; if (t >= 16) dst = C.out + OFF_YP + ((size_t)b * 4096 + (t - 16)) * 1024; }
                    else if (row < MR) dst = C.out + OFF_YS + (size_t)(row - NPR) * 1024;
                }
                float ss = 0.f;
#pragma unroll
                for (int bj = 0; bj < 2; ++bj) {
                    const int col = 256 * u.pn + 128 * bj + lc8;
                    const f32x4 hv0 = unpk4((u32x2){h[m2][bj].x, h[m2][bj].y}) + acc[ai][bj][m][0] * E.alpha, hv1 = unpk4((u32x2){h[m2][bj].z, h[m2][bj].w}) + acc[ai][bj][m][1] * E.alpha;
                    if (E.final_) { *(f32x4*)(dst + col) = hv0; *(f32x4*)(dst + col + 4) = hv1; }
                    else {
                        *(u32x4*)(C.XB + (size_t)row * DM + col) = pk8(hv0, hv1);
                        ss += hv0[0] * hv0[0] + hv0[1] * hv0[1] + hv0[2] * hv0[2] + hv0[3] * hv0[3] + hv1[0] * hv1[0] + hv1[1] * hv1[1] + hv1[2] * hv1[2] + hv1[3] * hv1[3];
                    }
                }
                if (!E.final_) {
                    ss += __shfl_xor(ss, 16); ss += __shfl_xor(ss, 32);
                    if (fq == 0) unsafeAtomicAdd(E.rss_out + row, ss);
                }
            }
        }
    } else {
        const int seg = u.seg;
#pragma unroll
        for (int ai = 0; ai < 2; ++ai)
#pragma unroll
        for (int mh = 0; mh < 2; ++mh) {
            u32x4 gq[2][2], mf[2][2];
#pragma unroll
            for (int m2 = 0; m2 < 2; ++m2)
#pragma unroll
                for (int bj = 0; bj < 2; ++bj) {
                    const int row = row0 + 128 * ai + 16 * (2 * mh + m2), col = 256 * u.pn + 128 * bj + lc8;
                    gq[m2][bj] = *(const u32x4*)(C.G + (size_t)row * 3072 + seg * 1024 + col);
                    if (seg > 0) mf[m2][bj] = *(const u32x4*)(C.MIXB + (size_t)row * DM + col); else mf[m2][bj] = (u32x4){0u, 0u, 0u, 0u};
                }
#pragma unroll
            for (int m2 = 0; m2 < 2; ++m2)
#pragma unroll
                for (int bj = 0; bj < 2; ++bj) {
                    const int m = 2 * mh + m2;
                    const int row = row0 + 128 * ai + 16 * m, col = 256 * u.pn + 128 * bj + lc8;
                    const f32x4 r0 = acc[ai][bj][m][0] * unpk4((u32x2){gq[m2][bj].x, gq[m2][bj].y}) + unpk4((u32x2){mf[m2][bj].x, mf[m2][bj].y});
                    const f32x4 r1 = acc[ai][bj][m][1] * unpk4((u32x2){gq[m2][bj].z, gq[m2][bj].w}) + unpk4((u32x2){mf[m2][bj].z, mf[m2][bj].w});
                    *(u32x4*)(C.MIXB + (size_t)row * DM + col) = pk8(r0, r1);
                }
        }
    }
}

template <bool PERM>
__device__ __forceinline__ void gemm_phase(LAS unsigned char* lds, const Gemm g, const Sched& S, const EpiDesc& E, const Ctx& C) {
    const int tid = opaque_tid(), wid = __builtin_amdgcn_readfirstlane(tid >> 6), lane = tid & 63, wr = wid >> 2, wc = wid & 3, fr = lane & 15, fq = lane >> 4;
    unsigned voffA[2], voffB[2];
#pragma unroll
    for (int i = 0; i < 2; ++i) { int R, Cc; stage_rc(tid * 16 + i * 8192, R, Cc); const int Rb = PERM ? (R & ~31) + perm32(R & 31) : R; voffA[i] = (unsigned)(R * g.lda + Cc) * 2u; voffB[i] = (unsigned)(Rb * g.ldb + Cc) * 2u; }
    const size_t kstep = (size_t)(BK * 2);
    const size_t hstepA = (size_t)HALF * g.lda * 2, hstepB = (size_t)HALF * g.ldb * 2;
    const size_t tstepA = 2 * hstepA, tstepB = 2 * hstepB;
    const unsigned ldsw = (unsigned)wid * 1024u;
    const int aoff = lds_byte(wr * 64 + fr, fq * 8), boff = lds_byte(wc * 32 + fr, fq * 8);
#define PG8_SA(b, h) (((b) * 2 + (h)) * HTB)
#define PG8_SB(b, h) ((4 + (b) * 2 + (h)) * HTB)
#define PG8_STAGE(bufoff, gbase, voff) do { _Pragma("unroll") for (int _i = 0; _i < 2; ++_i) \
        __builtin_amdgcn_global_load_lds((const unsigned*)((const char*)(gbase) + (voff)[_i]), (LAS unsigned*)(lds + (bufoff) + ldsw + _i * 8192), 16, 0, 0); } while (0)
#define PG8_LDA(dst, b, h) do { _Pragma("unroll") for (int m = 0; m < 4; ++m) _Pragma("unroll") for (int k = 0; k < 2; ++k) dst[m][k] = *(const LAS bf16x8*)(lds + PG8_SA(b, h) + aoff + m * 2048 + k * 1024); } while (0)
#define PG8_LDB(dst, b, h) do { _Pragma("unroll") for (int n = 0; n < 2; ++n) _Pragma("unroll") for (int k = 0; k < 2; ++k) dst[n][k] = *(const LAS bf16x8*)(lds + PG8_SB(b, h) + boff + n * 2048 + k * 1024); } while (0)
#define PG8_MMA(ai, bj, At, Bt) do { __builtin_amdgcn_s_setprio(3); _Pragma("unroll") for (int m = 0; m < 4; ++m) _Pragma("unroll") for (int n = 0; n < 2; ++n) _Pragma("unroll") for (int k = 0; k < 2; ++k) \
        acc[ai][bj][m][n] = __builtin_amdgcn_mfma_f32_16x16x32_bf16(Bt[n][k], At[m][k], acc[ai][bj][m][n], 0, 0, 0); __builtin_amdgcn_s_setprio(0); } while (0)
#define PG8_WAIT_V(n) asm volatile("s_waitcnt vmcnt(" #n ")" ::: "memory")
#define PG8_WAIT_L(n) asm volatile("s_waitcnt lgkmcnt(" #n ")" ::: "memory")
#define PG8_BAR __builtin_amdgcn_s_barrier()
#define PG8_SCHED __builtin_amdgcn_sched_barrier(0)
    Unit cur, nxt; int ui = 0;
    if (!S.next(0, cur)) return;
    f32x4 acc[2][2][4][2];
#pragma unroll
    for (int a = 0; a < 2; ++a)
#pragma unroll
        for (int b = 0; b < 2; ++b)
#pragma unroll
            for (int m = 0; m < 4; ++m)
#pragma unroll
                for (int n = 0; n < 2; ++n) acc[a][b][m][n] = (f32x4){0.f, 0.f, 0.f, 0.f};
    bf16x8 At[4][2], B0[2][2], B1[2][2];
    const char* cA = (const char*)g.A + (size_t)cur.pm * tstepA + (size_t)cur.kofs * 2; const char* cB = (const char*)g.Bt + (size_t)cur.pn * tstepB + (size_t)cur.kofs * 2;
    PG8_STAGE(PG8_SB(0, 0), cB, voffB); PG8_STAGE(PG8_SB(0, 1), cB + hstepB, voffB); PG8_STAGE(PG8_SA(0, 0), cA, voffA); PG8_STAGE(PG8_SA(0, 1), cA + hstepA, voffA);
    if (wr == 1) PG8_BAR;
    PG8_WAIT_V(2); PG8_BAR;
    PG8_STAGE(PG8_SB(1, 0), cB + kstep, voffB); PG8_STAGE(PG8_SA(1, 0), cA + kstep, voffA); PG8_STAGE(PG8_SB(1, 1), cB + hstepB + kstep, voffB);
    PG8_WAIT_V(6); PG8_BAR;
    for (;;) {
        const bool has_next = S.next(ui + 1, nxt);
        const char* nA = has_next ? (const char*)g.A + (size_t)nxt.pm * tstepA + (size_t)nxt.kofs * 2 : cA; const char* nB = has_next ? (const char*)g.Bt + (size_t)nxt.pn * tstepB + (size_t)nxt.kofs * 2 : cB;
        const int nt = cur.nt;
        for (int t = 0; t < nt; t += 2) {
            const bool last = (t == nt - 2);
            const char* a1 = cA + (size_t)(t + 1) * kstep;
            const char* a2 = last ? nA : cA + (size_t)(t + 2) * kstep; const char* b2 = last ? nB : cB + (size_t)(t + 2) * kstep;
            const char* a3 = a2 + kstep; const char* b3 = b2 + kstep;
            PG8_LDB(B0, 0, 0); PG8_LDB(B1, 0, 1); PG8_SCHED; PG8_LDA(At, 0, 0); PG8_STAGE(PG8_SA(1, 1), a1 + hstepA, voffA);
            PG8_WAIT_V(8); PG8_WAIT_L(0); PG8_BAR; PG8_MMA(0, 0, At, B0); PG8_MMA(0, 1, At, B1); PG8_BAR; PG8_SCHED;
            PG8_LDA(At, 0, 1); PG8_STAGE(PG8_SB(0, 0), b2, voffB); PG8_STAGE(PG8_SB(0, 1), b2 + hstepB, voffB); PG8_STAGE(PG8_SA(0, 0), a2, voffA);
            PG8_WAIT_V(8); PG8_WAIT_L(0); PG8_BAR; PG8_MMA(1, 0, At, B0); PG8_MMA(1, 1, At, B1); PG8_BAR; PG8_SCHED;
            PG8_LDB(B0, 1, 0); PG8_LDB(B1, 1, 1); PG8_SCHED; PG8_LDA(At, 1, 0); PG8_STAGE(PG8_SA(0, 1), a2 + hstepA, voffA);
            PG8_WAIT_V(8); PG8_WAIT_L(0); PG8_BAR; PG8_MMA(0, 0, At, B0); PG8_MMA(0, 1, At, B1); PG8_BAR; PG8_SCHED;
            PG8_LDA(At, 1, 1); PG8_STAGE(PG8_SB(1, 0), b3, voffB); PG8_STAGE(PG8_SB(1, 1), b3 + hstepB, voffB); PG8_STAGE(PG8_SA(1, 0), a3, voffA);
            PG8_WAIT_V(8); PG8_WAIT_L(0); PG8_BAR; PG8_MMA(1, 0, At, B0); PG8_MMA(1, 1, At, B1); PG8_BAR; PG8_SCHED;
        }
        if (wr == 0) PG8_BAR;
        if (PERM) {
            if ((PERM_MASK & 1) && E.kind == EK_SWIGLU) epilogue_p<EK_SWIGLU>(acc, cur, E, C, wr, wc, fr, fq);
            else if ((PERM_MASK & 2) && E.kind == EK_RESID) epilogue_p<EK_RESID>(acc, cur, E, C, wr, wc, fr, fq);
            else if ((PERM_MASK & 4) && E.kind == EK_PROJ) epilogue_p<EK_PROJ>(acc, cur, E, C, wr, wc, fr, fq);
            else if ((PERM_MASK & 8) && E.kind == EK_BRANCH) epilogue_p<EK_BRANCH>(acc, cur, E, C, wr, wc, fr, fq);
        } else {
            if (!(PERM_MASK & 1) && E.kind == EK_SWIGLU) epilogue<EK_SWIGLU>(acc, cur, E, C, wr, wc, fr, fq);
            else if (!(PERM_MASK & 2) && E.kind == EK_RESID) epilogue<EK_RESID>(acc, cur, E, C, wr, wc, fr, fq);
            else if (!(PERM_MASK & 4) && E.kind == EK_PROJ) epilogue<EK_PROJ>(acc, cur, E, C, wr, wc, fr, fq);
            else if (!(PERM_MASK & 8) && E.kind == EK_BRANCH) epilogue<EK_BRANCH>(acc, cur, E, C, wr, wc, fr, fq);
        }
        if (!has_next) break;
#pragma unroll
        for (int a = 0; a < 2; ++a)
#pragma unroll
            for (int b = 0; b < 2; ++b)
#pragma unroll
                for (int m = 0; m < 4; ++m)
#pragma unroll
                    for (int n = 0; n < 2; ++n) acc[a][b][m][n] = (f32x4){0.f, 0.f, 0.f, 0.f};
        cur = nxt; cA = nA; cB = nB; ++ui;
        if (wr == 1) PG8_BAR;
    }
    PG8_WAIT_V(0);
    PG8_BAR;
#undef PG8_SA
#undef PG8_SB
#undef PG8_STAGE
#undef PG8_LDA
#undef PG8_LDB
#undef PG8_MMA
#undef PG8_WAIT_V
#undef PG8_WAIT_L
#undef PG8_BAR
#undef PG8_SCHED
}
__device__ __forceinline__ void small_unit(const Gemm g, const EpiDesc& E, const Ctx& C, int su, unsigned char* shm) {
    const int tid = opaque_tid(), lane = tid & 63, w = __builtin_amdgcn_readfirstlane(tid >> 6), m = lane & 31, hi = lane >> 5;
    const int row0 = 16384 + 64 * (su >> 4), col0 = 64 * (su & 15);
    int k_lo, k_len;
    if (E.kind == EK_BRANCH) { k_len = 128; k_lo = 128 * w; }
    else { k_len = (E.kind == EK_RESID && g.lda == DFF) ? DFF / 8 : DM / 8; k_lo = k_len * w; }
    const bf16_t* ap = g.A + (size_t)(row0 + m) * g.lda + k_lo + 8 * hi;
    const bf16_t* bp = g.Bt + (size_t)(col0 + m) * g.ldb + k_lo + 8 * hi;
    const size_t a32 = (size_t)32 * g.lda, b32 = (size_t)32 * g.ldb;
    f32x16 acc[2][2];
#pragma unroll
    for (int i = 0; i < 2; ++i)
#pragma unroll
        for (int j = 0; j < 2; ++j)
#pragma unroll
            for (int r = 0; r < 16; ++r) acc[i][j][r] = 0.f;
    const int nsteps = k_len >> 5;
    for (int s0 = 0; s0 < nsteps; s0 += 4) {
        bf16x8 fa[4][4], fb[4][4];
#pragma unroll
        for (int u = 0; u < 4; ++u) {
            const int k = 32 * min(s0 + u, nsteps - 1);
            fa[u][0] = *(const bf16x8*)(ap + k); fa[u][1] = *(const bf16x8*)(ap + a32 + k); fa[u][2] = *(const bf16x8*)(ap + k + 16); fa[u][3] = *(const bf16x8*)(ap + a32 + k + 16);
            fb[u][0] = *(const bf16x8*)(bp + k); fb[u][1] = *(const bf16x8*)(bp + b32 + k); fb[u][2] = *(const bf16x8*)(bp + k + 16); fb[u][3] = *(const bf16x8*)(bp + b32 + k + 16);
        }
#pragma unroll
        for (int u = 0; u < 4; ++u) {
            if (s0 + u < nsteps) {
                acc[0][0] = __builtin_amdgcn_mfma_f32_32x32x16_bf16(fa[u][0], fb[u][0], acc[0][0], 0, 0, 0); acc[0][1] = __builtin_amdgcn_mfma_f32_32x32x16_bf16(fa[u][0], fb[u][1], acc[0][1], 0, 0, 0);
                acc[1][0] = __builtin_amdgcn_mfma_f32_32x32x16_bf16(fa[u][1], fb[u][0], acc[1][0], 0, 0, 0); acc[1][1] = __builtin_amdgcn_mfma_f32_32x32x16_bf16(fa[u][1], fb[u][1], acc[1][1], 0, 0, 0);
                acc[0][0] = __builtin_amdgcn_mfma_f32_32x32x16_bf16(fa[u][2], fb[u][2], acc[0][0], 0, 0, 0); acc[0][1] = __builtin_amdgcn_mfma_f32_32x32x16_bf16(fa[u][2], fb[u][3], acc[0][1], 0, 0, 0);
                acc[1][0] = __builtin_amdgcn_mfma_f32_32x32x16_bf16(fa[u][3], fb[u][2], acc[1][0], 0, 0, 0); acc[1][1] = __builtin_amdgcn_mfma_f32_32x32x16_bf16(fa[u][3], fb[u][3], acc[1][1], 0, 0, 0);
            }
        }
    }
    float* P = (float*)shm + w * 4096;
#pragma unroll
    for (int i = 0; i < 2; ++i)
#pragma unroll
        for (int j = 0; j < 2; ++j)
#pragma unroll
            for (int r = 0; r < 16; ++r) P[(32 * i + crow(r, hi)) * 64 + 32 * j + m] = acc[i][j][r];
    __syncthreads();
    {
        const int r = tid >> 3, cg8 = (tid & 7) * 8, row = row0 + r, col = col0 + cg8;
        const float* pp = (const float*)shm + r * 64 + cg8;
        f32x4 v0, v1;
        if (E.kind == EK_BRANCH) {
            const bf16_t* gp = C.G + (size_t)row * 3072 + col;
            f32x4 s0 = *(const f32x4*)(pp) + *(const f32x4*)(pp + 4096), s1 = *(const f32x4*)(pp + 4) + *(const f32x4*)(pp + 4096 + 4);
            f32x4 t0 = *(const f32x4*)(pp + 2 * 4096) + *(const f32x4*)(pp + 3 * 4096), t1 = *(const f32x4*)(pp + 2 * 4096 + 4) + *(const f32x4*)(pp + 3 * 4096 + 4);
            f32x4 u0 = (*(const f32x4*)(pp + 4 * 4096) + *(const f32x4*)(pp + 5 * 4096)) + (*(const f32x4*)(pp + 6 * 4096) + *(const f32x4*)(pp + 7 * 4096));
            f32x4 u1 = (*(const f32x4*)(pp + 4 * 4096 + 4) + *(const f32x4*)(pp + 5 * 4096 + 4)) + (*(const f32x4*)(pp + 6 * 4096 + 4) + *(const f32x4*)(pp + 7 * 4096 + 4));
            const u32x4 ga = *(const u32x4*)(gp), gb = *(const u32x4*)(gp + 1024), gc = *(const u32x4*)(gp + 2048);
            v0 = s0 * unpk4((u32x2){ga.x, ga.y}) + t0 * unpk4((u32x2){gb.x, gb.y}) + u0 * unpk4((u32x2){gc.x, gc.y});
            v1 = s1 * unpk4((u32x2){ga.z, ga.w}) + t1 * unpk4((u32x2){gb.z, gb.w}) + u1 * unpk4((u32x2){gc.z, gc.w});
            const u32x2 p0 = pk4(v0), p1 = pk4(v1);
            *(u32x4*)(C.MIXB + (size_t)row * DM + col) = (u32x4){p0.x, p0.y, p1.x, p1.y};
        } else {
            v0 = (f32x4){0.f, 0.f, 0.f, 0.f}; v1 = v0;
#pragma unroll
            for (int ww = 0; ww < 8; ++ww) { v0 = v0 + *(const f32x4*)(pp + ww * 4096); v1 = v1 + *(const f32x4*)(pp + ww * 4096 + 4); }
            const u32x4 hb = *(const u32x4*)(C.XB + (size_t)row * DM + col);
            const f32x4 h0 = unpk4((u32x2){hb.x, hb.y}) + v0 * E.alpha, h1 = unpk4((u32x2){hb.z, hb.w}) + v1 * E.alpha;
            const u32x2 p0 = pk4(h0), p1 = pk4(h1);
            if (!E.final_) *(u32x4*)(C.XB + (size_t)row * DM + col) = (u32x4){p0.x, p0.y, p1.x, p1.y};
            if (E.final_) {
                float* dst = nullptr;
                if (row < NPR) { const int b = row / TP, t = row - b * TP; if (t >= 16) dst = C.out + OFF_YP + ((size_t)b * 4096 + (t - 16)) * 1024; }
                else dst = C.out + OFF_YS + (size_t)(row - NPR) * 1024;
                if (dst) { *(f32x4*)(dst + col) = h0; *(f32x4*)(dst + col + 4) = h1; }
            }
            float ss = h0[0] * h0[0] + h0[1] * h0[1] + h0[2] * h0[2] + h0[3] * h0[3] + h1[0] * h1[0] + h1[1] * h1[1] + h1[2] * h1[2] + h1[3] * h1[3];
            ss += __shfl_xor(ss, 1); ss += __shfl_xor(ss, 2); ss += __shfl_xor(ss, 4);
            if ((tid & 7) == 0) unsafeAtomicAdd(E.rss_out + row, ss);
        }
    }
    __syncthreads();
}
}

__device__ __forceinline__ float wave_sum(float v) {
#pragma unroll
    for (int o = 1; o < 64; o <<= 1) v += __shfl_xor(v, o);
    return v;
}
__device__ __forceinline__ const float* src_col(int kind, const float* W, const float* W2, int c) {
    if (kind == 1) { if (PERM_MASK & 1) { const int pn = c >> 8, sl = c & 255; return ((sl >> 7) ? W2 : W) + 128 * pn + (sl & 127); } const int Gc = c >> 5, n = (c >> 4) & 1, i = c & 15; return (n ? W2 : W) + 16 * Gc + i; }
    if (kind == 2) { const int pn = c >> 8; if (pn >= 4 && pn < 8) { const int s = c & 255, hl = (s >> 5) & 3, d = 32 * (s >> 7) + (s & 31); return W + 256 * pn + 64 * hl + d; } return W + c; }
    return W + c;
}
__device__ __forceinline__ void transpose_item(int kind, const float* W, const float* W2, int srcN, const float* gain, bf16_t* WT, int ldt, int kb, int cb, float* scr, int lane) {
    const int k0 = 64 * kb, c0 = 64 * cb, c4 = (lane & 15) * 4, kr = lane >> 4;
    const float* p = src_col(kind, W, W2, c0 + c4) + (size_t)(k0 + kr) * srcN;
    f32x4 v[16];
#pragma unroll
    for (int i = 0; i < 16; ++i) v[i] = *(const f32x4*)(p + (size_t)(4 * i) * srcN);
#pragma unroll
    for (int i = 0; i < 16; ++i) {
        const int kk = 4 * i + kr; const float gs = gain ? gain[k0 + kk] : 1.f;
        float* d = scr + kk * 65 + c4;
        d[0] = v[i][0] * gs; d[1] = v[i][1] * gs; d[2] = v[i][2] * gs; d[3] = v[i][3] * gs;
    }
    asm volatile("s_waitcnt lgkmcnt(0)" ::: "memory");
    const int c8 = lane & 7;
#pragma unroll
    for (int j = 0; j < 8; ++j) { const int n = (lane >> 3) + 8 * j; const float* s = scr + (8 * c8) * 65 + n;
        u32x4 o; o.x = cvt_pk_bf16(s[0 * 65], s[1 * 65]); o.y = cvt_pk_bf16(s[2 * 65], s[3 * 65]); o.z = cvt_pk_bf16(s[4 * 65], s[5 * 65]); o.w = cvt_pk_bf16(s[6 * 65], s[7 * 65]);
        *(u32x4*)(WT + (size_t)(c0 + n) * ldt + k0 + 8 * c8) = o; }
    asm volatile("s_waitcnt lgkmcnt(0)" ::: "memory");
}

constexpr int I_GU = 16 * 88, I_DN = 44 * 16, I_IN = 16 * 88, I_BP = 4 * 16, I_BA = 8 * 16, I_OUT = 16 * 16;
constexpr int I_LAYER = 2 * I_GU + 2 * I_DN + I_IN + 2 * I_BP + I_BA + I_OUT;
__device__ __forceinline__ void convert_items(const Ctx& C, unsigned char* shm, int it_lo, int it_hi, int gw0, int ngw) {
    const int tid = opaque_tid(), lane = tid & 63, wave = tid >> 6;
    float* scr = (float*)(shm + wave * 16640);
    for (int it = it_lo + gw0; it < it_hi; it += ngw) {
        const int l = it / I_LAYER; int r = it - l * I_LAYER;
        unsigned char* wl = C.ws + WS_W + (size_t)l * W_LAYER;
        if (r < I_GU) { transpose_item(1, C.in[8] + (size_t)l * DM * DFF, C.in[9] + (size_t)l * DM * DFF, DFF, C.in[7] + l * DM, (bf16_t*)(wl + W_GU1), DM, r / 88, r % 88, scr, lane); continue; } r -= I_GU;
        if (r < I_GU) { transpose_item(1, C.in[23] + (size_t)l * DM * DFF, C.in[24] + (size_t)l * DM * DFF, DFF, C.in[22] + l * DM, (bf16_t*)(wl + W_GU2), DM, r / 88, r % 88, scr, lane); continue; } r -= I_GU;
        if (r < I_DN) { transpose_item(0, C.in[10] + (size_t)l * DFF * DM, nullptr, DM, nullptr, (bf16_t*)(wl + W_DN1), DFF, r / 16, r % 16, scr, lane); continue; } r -= I_DN;
        if (r < I_DN) { transpose_item(0, C.in[25] + (size_t)l * DFF * DM, nullptr, DM, nullptr, (bf16_t*)(wl + W_DN2), DFF, r / 16, r % 16, scr, lane); continue; } r -= I_DN;
        if (r < I_IN) { transpose_item(2, C.in[12] + (size_t)l * DM * NIN, nullptr, NIN, C.in[11] + l * DM, (bf16_t*)(wl + W_IN), DM, r / 88, r % 88, scr, lane); continue; } r -= I_IN;
        if (r < I_BP) { transpose_item(0, C.in[15] + (size_t)l * 256 * DM, nullptr, DM, nullptr, (bf16_t*)(wl + W_BR), DM, r / 16, r % 16, scr, lane); continue; } r -= I_BP;
        if (r < I_BP) { transpose_item(0, C.in[17] + (size_t)l * 256 * DM, nullptr, DM, nullptr, (bf16_t*)(wl + W_BR) + 256, DM, r / 16, r % 16, scr, lane); continue; } r -= I_BP;
        if (r < I_BA) { transpose_item(0, C.in[20] + (size_t)l * 512 * DM, nullptr, DM, nullptr, (bf16_t*)(wl + W_BR) + 512, DM, r / 16, r % 16, scr, lane); continue; } r -= I_BA;
        transpose_item(0, C.in[21] + (size_t)l * DM * DM, nullptr, DM, nullptr, (bf16_t*)(wl + W_OUT), DM, r / 16, r % 16, scr, lane);
    }
}

__device__ __forceinline__ void prologue_phase(const Ctx& C, unsigned char* shm) {
    const int tid = opaque_tid(), lane = tid & 63, wave = tid >> 6;
    const int gw = blockIdx.x * 8 + wave, NGW = gridDim.x * 8;
    convert_items(C, shm, 0, (gridDim.x > 160) ? I_LAYER : 2 * I_LAYER, gw, NGW);
    for (int m = gw; m < MP; m += NGW) {
        f32x4 v[4];
        if (m < MR) {
            const float* src;
            if (m < NPR) { const int b = m / TP, t = m - b * TP; src = (t < 16) ? C.in[6] + (size_t)t * DM : C.in[0] + ((size_t)b * 4096 + (t - 16)) * DM; }
            else src = C.in[1] + (size_t)(m - NPR) * DM;
#pragma unroll
            for (int j = 0; j < 4; ++j) v[j] = *((const f32x4*)src + lane + 64 * j);
        } else {
#pragma unroll
            for (int j = 0; j < 4; ++j) v[j] = (f32x4){0.f, 0.f, 0.f, 0.f};
        }
        float s = 0.f;
#pragma unroll
        for (int j = 0; j < 4; ++j) { s += v[j][0] * v[j][0] + v[j][1] * v[j][1] + v[j][2] * v[j][2] + v[j][3] * v[j][3];
            *((u32x2*)(C.XB + (size_t)m * DM) + lane + 64 * j) = pk4(v[j]); }
        s = wave_sum(s);
        if (lane == 0) C.RSS[m] = s;
        if (lane >= 1 && lane < 7) C.RSS[(size_t)lane * MP + m] = 0.f;
    }
}

typedef float f32x2 __attribute__((ext_vector_type(2)));
template <bool MASK>
__device__ __forceinline__ void sb_math(const f32x16& st, int kb, int tq, int hi, float& carry, bf16x8& p0, bf16x8& p1) {
    f32x2 e2[8], x2[8];
#pragma unroll
    for (int p = 0; p < 8; ++p) {
        float e0 = __builtin_amdgcn_exp2f(st[2 * p]), e1 = __builtin_amdgcn_exp2f(st[2 * p + 1]);
        if (MASK) { const int key = kb + crow(2 * p, hi); e0 = (key >= 0 && key < tq) ? e0 : 0.f; e1 = (key + 1 >= 0 && key + 1 < tq) ? e1 : 0.f; }
        e2[p] = (f32x2){e0, e1};
        const f32x2 d = e2[p] + (f32x2){1.f, 1.f};
        x2[p] = (f32x2){__builtin_amdgcn_rcpf(d.x), __builtin_amdgcn_rcpf(d.y)};
    }
    float g0[4], g1[4];
#pragma unroll
    for (int c = 0; c < 4; ++c) {
        const float X3 = x2[2 * c + 1].y, X2 = x2[2 * c + 1].x * X3, X1 = x2[2 * c].y * X2, X0 = x2[2 * c].x * X1;
        x2[2 * c] = (f32x2){X0, X1}; x2[2 * c + 1] = (f32x2){X2, X3};
        auto rr = __builtin_amdgcn_permlane32_swap(__float_as_uint(X0), __float_as_uint(X0), false, false);
        g0[c] = __uint_as_float(rr[0]); g1[c] = __uint_as_float(rr[1]);
    }
    const float T7 = carry, T6 = T7 * g1[3], T5 = T6 * g0[3], T4 = T5 * g1[2], T3 = T4 * g0[2], T2 = T3 * g1[1], T1 = T2 * g0[1], T0 = T1 * g1[0];
    carry = T0 * g0[0];
    const float t0 = hi ? T1 : T0, t1 = hi ? T3 : T2, t2 = hi ? T5 : T4, t3 = hi ? T7 : T6;
    f32x2 a2[8];
    { const f32x2 tb = (f32x2){t0, t0}; a2[0] = e2[0] * (x2[0] * tb); a2[1] = e2[1] * (x2[1] * tb); }
    { const f32x2 tb = (f32x2){t1, t1}; a2[2] = e2[2] * (x2[2] * tb); a2[3] = e2[3] * (x2[3] * tb); }
    { const f32x2 tb = (f32x2){t2, t2}; a2[4] = e2[4] * (x2[4] * tb); a2[5] = e2[5] * (x2[5] * tb); }
    { const f32x2 tb = (f32x2){t3, t3}; a2[6] = e2[6] * (x2[6] * tb); a2[7] = e2[7] * (x2[7] * tb); }
    u32x4 q0, q1;
    q0.x = cvt_pk_bf16(a2[0].x, a2[0].y); q0.y = cvt_pk_bf16(a2[1].x, a2[1].y); q0.z = cvt_pk_bf16(a2[2].x, a2[2].y); q0.w = cvt_pk_bf16(a2[3].x, a2[3].y);
    q1.x = cvt_pk_bf16(a2[4].x, a2[4].y); q1.y = cvt_pk_bf16(a2[5].x, a2[5].y); q1.z = cvt_pk_bf16(a2[6].x, a2[6].y); q1.w = cvt_pk_bf16(a2[7].x, a2[7].y);
    p0 = __builtin_bit_cast(bf16x8, q0); p1 = __builtin_bit_cast(bf16x8, q1);
}

constexpr int AT_KROW = 144, AT_VROW = 136, AT_KBYTES = 64 * AT_KROW, AT_BUF = AT_KBYTES + 64 * AT_VROW;

__device__ __forceinline__ void attn_main_unit(const Ctx& C, int b, int h, int j, unsigned char* shm) {
    const int tid = opaque_tid(), lane = tid & 63, qi = lane & 31, hi = lane >> 5, w = __builtin_amdgcn_readfirstlane(tid >> 6);
    const int tq0 = 16 + 256 * j + 32 * w, tq = tq0 + qi;
    const size_t qrow = (size_t)b * TP + tq;
    bf16x8 qf[4];
#pragma unroll
    for (int s = 0; s < 4; ++s) qf[s] = *(const bf16x8*)(C.Q + qrow * 512 + 64 * h + 16 * s + 8 * hi);
    f32x16 o0, o1;
#pragma unroll
    for (int r = 0; r < 16; ++r) { o0[r] = 0.f; o1[r] = 0.f; }
    float carry = 1.f;
    const int itop = 4 * j + 4, wtop = 4 * j + (32 * w + 94) / 64;
    const int srow = tid >> 3, sch = tid & 7;
    const bf16_t* kg = C.KP + ((ptrdiff_t)b * TP - 48 + srow) * 512 + 64 * h + 8 * sch;
    const bf16_t* vg = C.VB + ((ptrdiff_t)b * TP - 48 + srow) * 512 + 64 * h + 8 * sch;
    u32x4 kreg = *(const u32x4*)(kg + (size_t)itop * 64 * 512), vreg = *(const u32x4*)(vg + (size_t)itop * 64 * 512);
    unsigned* flg = (unsigned*)(shm + 2 * AT_BUF);
    if (tid < 2) flg[tid] = 0u;
    bool wdone = false;
    for (int i = itop; i >= 0; --i) {
        unsigned char* kb_ = shm + (i & 1) * AT_BUF; unsigned char* vb_ = kb_ + AT_KBYTES;
        *(u32x4*)(kb_ + srow * AT_KROW + sch * 16) = kreg;
        {
            bf16_t* vw = (bf16_t*)(vb_ + (8 * sch) * AT_VROW + srow * 2);
            vw[0 * (AT_VROW / 2)] = (bf16_t)(vreg.x & 0xffffu); vw[1 * (AT_VROW / 2)] = (bf16_t)(vreg.x >> 16);
            vw[2 * (AT_VROW / 2)] = (bf16_t)(vreg.y & 0xffffu); vw[3 * (AT_VROW / 2)] = (bf16_t)(vreg.y >> 16);
            vw[4 * (AT_VROW / 2)] = (bf16_t)(vreg.z & 0xffffu); vw[5 * (AT_VROW / 2)] = (bf16_t)(vreg.z >> 16);
            vw[6 * (AT_VROW / 2)] = (bf16_t)(vreg.w & 0xffffu); vw[7 * (AT_VROW / 2)] = (bf16_t)(vreg.w >> 16);
        }
        if (i > 0) { kreg = *(const u32x4*)(kg + (size_t)(i - 1) * 64 * 512); vreg = *(const u32x4*)(vg + (size_t)(i - 1) * 64 * 512); }
        asm volatile("s_waitcnt lgkmcnt(0)" ::: "memory"); __builtin_amdgcn_s_barrier(); asm volatile("" ::: "memory");
        if (i < itop) { const unsigned fw = (unsigned)__builtin_amdgcn_readfirstlane((int)((volatile unsigned*)flg)[(i + 1) & 1]); if (fw == 0xFFu) break; }
        if (i <= wtop && !wdone) {
#pragma unroll
            for (int sub = 1; sub >= 0; --sub) {
                const int kb = 64 * i - 48 + 32 * sub;
                if (kb > tq0 + 30 || kb + 31 < 0) continue;
                const bool need_mask = (kb + 31 >= tq0) || (kb < 0);
                f32x16 st;
#pragma unroll
                for (int r = 0; r < 16; ++r) st[r] = 0.f;
#pragma unroll
                for (int s = 0; s < 4; ++s) { const bf16x8 kf = *(const bf16x8*)(kb_ + (32 * sub + qi) * AT_KROW + 32 * s + 16 * hi); st = __builtin_amdgcn_mfma_f32_32x32x16_bf16(kf, qf[s], st, 0, 0, 0); }
                bf16x8 p0, p1;
                if (need_mask) sb_math<true>(st, kb, tq, hi, carry, p0, p1); else sb_math<false>(st, kb, tq, hi, carry, p0, p1);
#pragma unroll
                for (int s = 0; s < 2; ++s) {
                    const unsigned char* vp0 = vb_ + qi * AT_VROW + (32 * sub + 16 * s + 4 * hi) * 2;
                    const unsigned char* vp1 = vp0 + 32 * AT_VROW;
                    const s16x4 a0 = *(const s16x4*)vp0, a1 = *(const s16x4*)(vp0 + 16), b0 = *(const s16x4*)vp1, b1 = *(const s16x4*)(vp1 + 16);
                    const bf16x8 v0 = (bf16x8){a0[0], a0[1], a0[2], a0[3], a1[0], a1[1], a1[2], a1[3]}, v1 = (bf16x8){b0[0], b0[1], b0[2], b0[3], b1[0], b1[1], b1[2], b1[3]};
                    o0 = __builtin_amdgcn_mfma_f32_32x32x16_bf16(v0, s ? p1 : p0, o0, 0, 0, 0);
                    o1 = __builtin_amdgcn_mfma_f32_32x32x16_bf16(v1, s ? p1 : p0, o1, 0, 0, 0);
                }
            }
            wdone = (__builtin_amdgcn_ballot_w64(carry != 0.f) == 0ull);
        }
        if (wdone && lane == 0) __hip_atomic_fetch_or(flg + (i & 1), 1u << w, __ATOMIC_RELAXED, __HIP_MEMORY_SCOPE_WORKGROUP);
    }
    bf16_t* op = C.PRE + qrow * DM + 512 + 64 * h + 4 * hi;
#pragma unroll
    for (int c = 0; c < 4; ++c) {
        *(u32x2*)(op + 8 * c) = (u32x2){cvt_pk_bf16(o0[4 * c], o0[4 * c + 1]), cvt_pk_bf16(o0[4 * c + 2], o0[4 * c + 3])};
        *(u32x2*)(op + 32 + 8 * c) = (u32x2){cvt_pk_bf16(o1[4 * c], o1[4 * c + 1]), cvt_pk_bf16(o1[4 * c + 2], o1[4 * c + 3])};
    }
    __syncthreads();
}

__device__ __forceinline__ void attn_skinny_unit(const Ctx& C, const float* k0, const float* v0, const float* k1, const float* v1, int S0, int S, int tq_base, size_t qrow_base, int h, unsigned char* shm) {
    const int tid = opaque_tid(), lane = tid & 63, qi = lane & 31, hi = lane >> 5, w = __builtin_amdgcn_readfirstlane(tid >> 6), q16 = qi & 15;
    const int tq = tq_base + q16;
    bf16x8 qf[4];
#pragma unroll
    for (int s = 0; s < 4; ++s) qf[s] = *(const bf16x8*)(C.Q + (qrow_base + q16) * 512 + 64 * h + 16 * s + 8 * hi);
    f32x16 o0, o1;
#pragma unroll
    for (int r = 0; r < 16; ++r) { o0[r] = 0.f; o1[r] = 0.f; }
    float carry = 1.f;
    const int nsb = (S + 31) >> 5, per = (nsb + 7) >> 3, sb_lo = w * per, sb_hi = min(nsb, sb_lo + per);
    for (int sb = sb_hi - 1; sb >= sb_lo; --sb) {
        const int kb = 32 * sb;
        const int key = min(kb + qi, S - 1);
        const float* kr = (key < S0 ? k0 + (size_t)key * 512 : k1 + (size_t)(key - S0) * 512) + 64 * h + 8 * hi;
        f32x16 st;
#pragma unroll
        for (int r = 0; r < 16; ++r) st[r] = 0.f;
#pragma unroll
        for (int s = 0; s < 4; ++s) {
            const f32x4 a = *(const f32x4*)(kr + 16 * s), bq = *(const f32x4*)(kr + 16 * s + 4);
            u32x4 pk; pk.x = cvt_pk_bf16(a[0], a[1]); pk.y = cvt_pk_bf16(a[2], a[3]); pk.z = cvt_pk_bf16(bq[0], bq[1]); pk.w = cvt_pk_bf16(bq[2], bq[3]);
            st = __builtin_amdgcn_mfma_f32_32x32x16_bf16(__builtin_bit_cast(bf16x8, pk), qf[s], st, 0, 0, 0);
        }
        bf16x8 p0, p1;
        sb_math<true>(st, kb, tq, hi, carry, p0, p1);
#pragma unroll
        for (int s = 0; s < 2; ++s) {
            float va[8], vb[8];
#pragma unroll
            for (int jj = 0; jj < 8; ++jj) {
                const int kk = min(kb + 16 * s + 4 * hi + (jj < 4 ? jj : jj + 4), S - 1);
                const float* vr = (kk < S0 ? v0 + (size_t)kk * 512 : v1 + (size_t)(kk - S0) * 512) + 64 * h + qi;
                va[jj] = vr[0]; vb[jj] = vr[32];
            }
            u32x4 pa, pb;
            pa.x = cvt_pk_bf16(va[0], va[1]); pa.y = cvt_pk_bf16(va[2], va[3]); pa.z = cvt_pk_bf16(va[4], va[5]); pa.w = cvt_pk_bf16(va[6], va[7]);
            pb.x = cvt_pk_bf16(vb[0], vb[1]); pb.y = cvt_pk_bf16(vb[2], vb[3]); pb.z = cvt_pk_bf16(vb[4], vb[5]); pb.w = cvt_pk_bf16(vb[6], vb[7]);
            o0 = __builtin_amdgcn_mfma_f32_32x32x16_bf16(__builtin_bit_cast(bf16x8, pa), s ? p1 : p0, o0, 0, 0, 0);
            o1 = __builtin_amdgcn_mfma_f32_32x32x16_bf16(__builtin_bit_cast(bf16x8, pb), s ? p1 : p0, o1, 0, 0, 0);
        }
    }
    float* OW = (float*)shm;
    float* RW = OW + 8 * 16 * 64;
    if (qi < 16) {
#pragma unroll
        for (int r = 0; r < 16; ++r) { OW[(w * 16 + qi) * 64 + crow(r, hi)] = o0[r]; OW[(w * 16 + qi) * 64 + 32 + crow(r, hi)] = o1[r]; }
        if (hi == 0) RW[w * 16 + qi] = carry;
    }
    __syncthreads();
    {
        const int q = tid >> 5, d = (tid & 31) * 2;
        float c = 1.f, a0 = 0.f, a1 = 0.f;
#pragma unroll
        for (int ww = 7; ww >= 0; --ww) { a0 += OW[(ww * 16 + q) * 64 + d] * c; a1 += OW[(ww * 16 + q) * 64 + d + 1] * c; c *= RW[ww * 16 + q]; }
        *(unsigned*)(C.PRE + (qrow_base + q) * DM + 512 + 64 * h + d) = cvt_pk_bf16(a0, a1);
    }
    __syncthreads();
}

template <int MODE>
__device__ __forceinline__ void poolconv_wave(const Ctx& C, int l, int ch, int g, int lane, float* PL) {
    constexpr bool samp = (MODE == 2);
    const int b = samp ? ch - 1028 : ch / 257, t0 = samp ? 0 : 16 * (ch % 257);
    const size_t rowbase = samp ? (size_t)NPR + 16 * b : (size_t)b * TP + t0;
    const int pos0 = samp ? 1024 : 0, c = 64 * g + lane, wnd = 2 << g;
    const float* spool = C.in[4] + ((size_t)l * 32 + b) * 15 * 256;
    const float* sconv = C.in[5] + ((size_t)l * 32 + b) * 2 * 256;
    float s[31], a[16];
#pragma unroll
    for (int r = 0; r < 31; ++r) {
        float v;
        if (MODE == 0) v = bf2f(C.PAB[(rowbase + (r - 15)) * DM + c]);
        else if (r >= 15) v = bf2f(C.PAB[(rowbase + (r - 15)) * DM + c]);
        else if (MODE == 2) v = spool[r * 256 + c];
        else v = 0.f;
        s[r] = v;
    }
#pragma unroll
    for (int i = 0; i < 16; ++i) a[i] = s[15 + i];
#pragma unroll
    for (int i = 30; i >= 1; --i) s[i] += s[i - 1];
    if (g >= 1) {
#pragma unroll
        for (int i = 30; i >= 3; --i) s[i] += s[i - 2];
    }
    if (g >= 2) {
#pragma unroll
        for (int i = 30; i >= 7; --i) s[i] += s[i - 4];
    }
    if (g >= 3) {
#pragma unroll
        for (int i = 30; i >= 15; --i) s[i] += s[i - 8];
    }
    float p[16], acc[16];
#pragma unroll
    for (int i = 0; i < 16; ++i) { const int pos = pos0 + t0 + i; p[i] = s[15 + i] / (float)min(pos + 1, wnd) - a[i]; acc[i] = 0.f; }
    const float* wp = C.in[13] + ((size_t)l * 4 + g) * 4096 + lane;
#pragma unroll
    for (int i = 0; i < 16; ++i) PL[i * 64 + lane] = p[i];
    asm volatile("s_waitcnt lgkmcnt(0)" ::: "memory");
#pragma unroll 2
    for (int k4 = 0; k4 < 16; ++k4) {
        const float w0 = wp[(4 * k4 + 0) * 64], w1 = wp[(4 * k4 + 1) * 64], w2 = wp[(4 * k4 + 2) * 64], w3 = wp[(4 * k4 + 3) * 64];
#pragma unroll
        for (int i = 0; i < 16; ++i) { const f32x4 pv = *(const f32x4*)(PL + i * 64 + 4 * k4); acc[i] += pv[0] * w0 + pv[1] * w1 + pv[2] * w2 + pv[3] * w3; }
    }
    asm volatile("s_waitcnt lgkmcnt(0)" ::: "memory");
    const float sc = C.in[14][l * 256 + c];
    const bool st_out = samp || t0 == 4096;
    float* pout = C.out + (samp ? OFF_PS + ((size_t)l * 32 + b) * 15 * 256 : OFF_PP + ((size_t)l * 4 + b) * 15 * 256) + c;
#pragma unroll
    for (int i = 0; i < 16; ++i) {
        C.PRE[(rowbase + i) * DM + c] = (bf16_t)(cvt_pk_bf16(acc[i] * sc, 0.f) & 0xffffu);
        if (st_out && i >= 1) pout[(i - 1) * 256] = a[i];
    }
    const float cw0 = C.in[16][(l * 3 + 0) * 256 + c], cw1 = C.in[16][(l * 3 + 1) * 256 + c], cw2 = C.in[16][(l * 3 + 2) * 256 + c];
    float e[18], gb[16];
#pragma unroll
    for (int i = 0; i < 18; ++i) {
        float v;
        if (MODE == 0 || i >= 2) { const bf16_t* r = C.PAB + (rowbase + (i - 2)) * DM; v = bf2f(r[768 + c]) * bf2f(r[256 + c]); }
        else if (MODE == 2) v = sconv[i * 256 + c];
        else v = 0.f;
        e[i] = v;
    }
#pragma unroll
    for (int i = 0; i < 16; ++i) gb[i] = bf2f(C.PAB[(rowbase + i) * DM + 512 + c]);
    float* cout = C.out + (samp ? OFF_CS + ((size_t)l * 32 + b) * 2 * 256 : OFF_CP + ((size_t)l * 4 + b) * 2 * 256) + c;
#pragma unroll
    for (int i = 0; i < 16; ++i) {
        const float y = gb[i] * (cw0 * e[i] + cw1 * e[i + 1] + cw2 * e[i + 2]);
        C.PRE[(rowbase + i) * DM + 256 + c] = (bf16_t)(cvt_pk_bf16(y, 0.f) & 0xffffu);
        if (st_out && i >= 14) cout[(i - 14) * 256] = e[i + 2];
    }
}

__device__ __forceinline__ void mixers_phase(const Ctx& C, int l, unsigned char* shm, int sub) {
    const int G = gridDim.x;
    if (sub & 1) for (int u = blockIdx.x; u < 256; u += G) {
        const int bh = (u & 7) * 4 + (u >> 6), jp = (u >> 3) & 7;
#ifndef NO_MAIN
        attn_main_unit(C, bh >> 3, bh & 7, 15 - jp, shm);
        attn_main_unit(C, bh >> 3, bh & 7, jp, shm);
#endif
    }
#ifndef NO_SKINNY
    if (sub & 2) for (int u = blockIdx.x; u < 288; u += G) {
        if (u < 256) {
            const int b = u >> 3, h = u & 7;
            attn_skinny_unit(C, C.in[2] + ((size_t)l * 32 + b) * 1024 * 512, C.in[3] + ((size_t)l * 32 + b) * 1024 * 512,
                             C.out + OFF_KS + ((size_t)l * NSR + 16 * b) * 512, C.out + OFF_VS + ((size_t)l * NSR + 16 * b) * 512, 1024, 1040, 1024, (size_t)NPR + 16 * b, h, shm);
        } else {
            const int b = (u - 256) >> 3, h = u & 7;
            const float* kp = C.out + OFF_KP + ((size_t)l * NPR + (size_t)b * TP) * 512; const float* vp = C.out + OFF_VP + ((size_t)l * NPR + (size_t)b * TP) * 512;
            attn_skinny_unit(C, kp, vp, kp, vp, 0, 16, 0, (size_t)b * TP, h, shm);
        }
    }
#endif
    if (sub & 4) {
        const int tid = opaque_tid(), lane = tid & 63, gw = blockIdx.x * 8 + __builtin_amdgcn_readfirstlane(tid >> 6), NGW = G * 8;
#ifndef NO_POOL
        for (int u = gw; u < 4240; u += NGW) {
            const int ch = u >> 2, g = u & 3; float* PL = (float*)shm + (tid >> 6) * 1024;
            if (ch >= 1028) poolconv_wave<2>(C, l, ch, g, lane, PL);
            else if (ch % 257 == 0) poolconv_wave<1>(C, l, ch, g, lane, PL);
            else poolconv_wave<0>(C, l, ch, g, lane, PL);
        }
#endif
    }
}

#define XB_TMO      128
#define XB_XCNT(j)  (256  + 64 * (j))
#define XB_XSUB(j)  (1280 + 64 * (j))
#define XB_XGEN(j)  (2304 + 64 * (j))
#define XB_TOP      3328
#define XB_TOPGEN   3392
#define XCD_BAR_WORDS 3456
#define XB_SPIN_CAP (1u << 18)
__device__ __forceinline__ unsigned xb_ld(unsigned* p)              { return __hip_atomic_load(p, __ATOMIC_RELAXED, __HIP_MEMORY_SCOPE_AGENT); }
__device__ __forceinline__ unsigned xb_add(unsigned* p, unsigned v) { return __hip_atomic_fetch_add(p, v, __ATOMIC_RELAXED, __HIP_MEMORY_SCOPE_AGENT); }
__device__ __forceinline__ unsigned xb_xcc_id() { return (unsigned)__builtin_amdgcn_s_getreg((3 << 11) | 20) & 0xFu; }
#define XB_SPIN(cond, bar) do { unsigned _sp = 0; while (cond) { __builtin_amdgcn_s_sleep(1); \
    if ((++_sp & 255u) == 0u) { if (xb_ld(&(bar)[XB_TMO])) break; if (_sp > XB_SPIN_CAP) { atomicAdd(&(bar)[XB_TMO], 1u); break; } } } } while (0)
struct XcdBarrier { unsigned* bar; unsigned x; volatile LAS unsigned* st; };
__device__ __forceinline__ XcdBarrier xcd_barrier_post(unsigned* bar, volatile LAS unsigned* st) {
    XcdBarrier b; b.bar = bar; b.x = xb_xcc_id(); b.st = st;
    if (threadIdx.x == 0) (void)xb_add(&bar[XB_XCNT(b.x)], 1u);
    return b;
}
__device__ __forceinline__ void xcd_barrier_complete(unsigned* bar, unsigned x, unsigned& nloc, unsigned& nx) {
    const unsigned G = gridDim.x * gridDim.y * gridDim.z;
    unsigned sum, cnt, mine, sp = 0u;
    for (;;) {
        sum = 0u; cnt = 0u; mine = 0u;
#pragma unroll
        for (unsigned j = 0; j < 16; ++j) { const unsigned c = xb_ld(&bar[XB_XCNT(j)]); sum += c; cnt += (c > 0u) ? 1u : 0u; mine = (j == x) ? c : mine; }
        if (sum == G) break;
        __builtin_amdgcn_s_sleep(1);
        if ((++sp & 255u) == 0u) { if (xb_ld(&bar[XB_TMO])) break; if (sp > XB_SPIN_CAP) { atomicAdd(&bar[XB_TMO], 1u); break; } }
    }
    nloc = mine > 0u ? mine : 1u; nx = cnt > 0u ? cnt : 1u;
}
__device__ __forceinline__ void xcd_barrier(const XcdBarrier& b) {
    asm volatile("s_waitcnt vmcnt(0)" ::: "memory");
    __syncthreads();
    if (threadIdx.x == 0) {
        unsigned* bar = b.bar;
        __builtin_amdgcn_s_waitcnt(0);
        unsigned nloc = b.st[0], nx = b.st[1];
        if (nloc == 0u) { xcd_barrier_complete(bar, b.x, nloc, nx); b.st[0] = nloc; b.st[1] = nx; }
        const unsigned old = xb_add(&bar[XB_XSUB(b.x)], 1u);
        const unsigned gen = old / nloc;
        if (old + 1u == (gen + 1u) * nloc) {
            __builtin_amdgcn_fence(__ATOMIC_RELEASE, "agent");
            asm volatile("s_waitcnt vmcnt(0)" ::: "memory");
            const unsigned og = xb_add(&bar[XB_TOP], 1u);
            const unsigned tg = og / nx;
            if (og + 1u == (tg + 1u) * nx) xb_add(&bar[XB_TOPGEN], 1u);
            else XB_SPIN(xb_ld(&bar[XB_TOPGEN]) == tg, bar);
            __builtin_amdgcn_fence(__ATOMIC_ACQUIRE, "agent");
            xb_add(&bar[XB_XGEN(b.x)], 1u);
            asm volatile("s_waitcnt vmcnt(0)" ::: "memory");
        } else {
            XB_SPIN(xb_ld(&bar[XB_XGEN(b.x)]) == gen, bar);
            __builtin_amdgcn_fence(__ATOMIC_ACQUIRE, "agent");
            asm volatile("s_waitcnt vmcnt(0)" ::: "memory");
        }
    }
    __syncthreads();
}

__global__ void __launch_bounds__(512, 2) mk_fwd(Args args) {
    extern __shared__ __attribute__((aligned(16))) unsigned char shm[];
    Ctx C;
    C.in = args.in; C.out = args.out; C.ws = args.ws;
    C.RSS = (float*)(args.ws + WS_RSS); C.XB = (bf16_t*)(args.ws + WS_XB); C.HF = (float*)(args.ws + WS_HF); C.ACT = (bf16_t*)(args.ws + WS_ACT); C.G = (bf16_t*)(args.ws + WS_G);
    C.PA = (float*)(args.ws + WS_PA); C.PAB = (bf16_t*)(args.ws + WS_PA); C.MIXF = (float*)(args.ws + WS_MIXF); C.MIXB = (bf16_t*)(args.ws + WS_MIXB); C.Q = (bf16_t*)(args.ws + WS_Q); C.KP = (bf16_t*)(args.ws + WS_KP) + 48 * 512; C.VT = (bf16_t*)(args.ws + WS_VT); C.VB = (bf16_t*)(args.ws + WS_VT) + 48 * 512; C.PRE = (bf16_t*)(args.ws + WS_PRE);
    volatile LAS unsigned* bst = (volatile LAS unsigned*)((LAS unsigned char*)shm + LDS_CTL);
    if (threadIdx.x < 4) bst[threadIdx.x] = 0u;
    __syncthreads();
    XcdBarrier bar; bar.bar = (unsigned*)(args.ws + WS_BAR); bar.x = 0; bar.st = bst;
    if (args.ph_hi - args.ph_lo > 1) bar = xcd_barrier_post((unsigned*)(args.ws + WS_BAR), bst);
    for (int ph = args.ph_lo; ph < args.ph_hi; ++ph) {
      for (int rep = 0; rep < ((ph == REP_PH) ? 2 : 1); ++rep) {
#ifndef NO_PRO
        if (ph == 0) prologue_phase(C, shm);
#else
        if (ph == 0) {}
#endif
        else {
            const int l = __builtin_amdgcn_readfirstlane((ph - 1) >> 3), s = __builtin_amdgcn_readfirstlane((ph - 1) & 7);
#ifndef NO_MIX
            if (s == 3) mixers_phase(C, l, shm, rep ? REP_SUB : 7);
#else
            if (s == 3) {}
#endif
            else {
                unsigned char* wl = args.ws + WS_W + (size_t)l * W_LAYER;
                pg8::Gemm g; pg8::Sched S; pg8::EpiDesc E;
                S.nM = MP / 256; S.G = gridDim.x; S.c = blockIdx.x; S.segs = 1;
                E.l = l; E.final_ = 0; E.alpha = 1.f; E.rss_in = C.RSS; E.rss_out = C.RSS;
                if (s == 0 || s == 6) { g.A = C.XB; g.lda = DM; g.Bt = (const bf16_t*)(wl + (s == 0 ? W_GU1 : W_GU2)); g.ldb = DM; S.nN = NIN / 256; S.nt_full = DM / 64; E.kind = pg8::EK_SWIGLU; E.rss_in = C.RSS + (size_t)(3 * l + (s == 0 ? 0 : 2)) * MP; }
                else if (s == 1 || s == 7) { g.A = C.ACT; g.lda = DFF; g.Bt = (const bf16_t*)(wl + (s == 1 ? W_DN1 : W_DN2)); g.ldb = DFF; S.nN = 4; S.nt_full = DFF / 64; E.kind = pg8::EK_RESID; E.alpha = 0.5f; E.rss_out = C.RSS + (size_t)(3 * l + (s == 1 ? 1 : 3)) * MP; E.final_ = (s == 7 && l == 1); }
                else if (s == 2) { g.A = C.XB; g.lda = DM; g.Bt = (const bf16_t*)(wl + W_IN); g.ldb = DM; S.nN = NIN / 256; S.nt_full = DM / 64; E.kind = pg8::EK_PROJ; E.rss_in = C.RSS + (size_t)(3 * l + 1) * MP; }
                else if (s == 4) { g.A = C.PRE; g.lda = DM; g.Bt = (const bf16_t*)(wl + W_BR); g.ldb = DM; S.nN = 4; S.nt_full = 0; S.segs = 3; E.kind = pg8::EK_BRANCH; }
                else { g.A = C.MIXB; g.lda = DM; g.Bt = (const bf16_t*)(wl + W_OUT); g.ldb = DM; S.nN = 4; S.nt_full = DM / 64; E.kind = pg8::EK_RESID; E.alpha = 1.f; E.rss_out = C.RSS + (size_t)(3 * l + 2) * MP; }
                if (S.nN == 4) S.nM = 64;
                S.nwg = S.nM * S.nN;
#ifndef NO_GEMM
                if (PERM_MASK == 0) pg8::gemm_phase<false>((LAS unsigned char*)shm, g, S, E, C);
                else if (PERM_MASK == 15) pg8::gemm_phase<true>((LAS unsigned char*)shm, g, S, E, C);
                else if ((PERM_MASK >> E.kind) & 1) pg8::gemm_phase<true>((LAS unsigned char*)shm, g, S, E, C);
                else pg8::gemm_phase<false>((LAS unsigned char*)shm, g, S, E, C);
                if (S.nN == 4) for (int su = blockIdx.x; su < 144; su += gridDim.x) pg8::small_unit(g, E, C, su, shm);
                if (S.nN == 4 && l == 0 && gridDim.x > 160 && blockIdx.x >= 144) {
                    const int part = (s == 1) ? 0 : (s == 4) ? 1 : (s == 5) ? 2 : 3;
                    const int lo = I_LAYER + (I_LAYER * part) / 4, hi = I_LAYER + (I_LAYER * (part + 1)) / 4;
                    convert_items(C, shm, lo, hi, (blockIdx.x - 144) * 8 + (threadIdx.x >> 6), (gridDim.x - 144) * 8);
                }
#endif
            }
        }
      }
        if (ph + 1 < args.ph_hi) { if (args.ph_hi > 1000) cg::this_grid().sync(); else xcd_barrier(bar); }
    }
}

extern "C" void kernel_launch(void* const* d_in, const int* in_sizes, int n_in, void* d_out, int out_size, void* d_ws, size_t ws_size, hipStream_t stream) {
    static int grid = 0;
    if (grid == 0) {
        if (n_in != 26 || (size_t)out_size != OUT_TOTAL || ws_size < WS_END) { fprintf(stderr, "kernel_launch: unexpected shapes: n_in %d out %d ws %zu (need %zu)\n", n_in, out_size, ws_size, (size_t)WS_END); grid = -1; return; }
        int dev = 0, cus = 0, per_cu = 0;
        hipGetDevice(&dev); hipDeviceGetAttribute(&cus, hipDeviceAttributeMultiprocessorCount, dev);
        if (hipFuncSetAttribute((const void*)mk_fwd, hipFuncAttributeMaxDynamicSharedMemorySize, LDS_BYTES) != hipSuccess) { fprintf(stderr, "kernel_launch: hipFuncSetAttribute failed\n"); grid = -1; return; }
        if (hipOccupancyMaxActiveBlocksPerMultiprocessor(&per_cu, (const void*)mk_fwd, 512, LDS_BYTES) != hipSuccess || per_cu < 1) { fprintf(stderr, "kernel_launch: occupancy query says %d\n", per_cu); per_cu = 1; }
        (void)hipGetLastError();
        grid = cus * per_cu;
    }
    if (grid < 0) return;
    Args a{};
    for (int i = 0; i < 26; ++i) a.in[i] = (const float*)d_in[i];
    a.out = (float*)d_out; a.ws = (unsigned char*)d_ws;
#if MK_ONE_LAUNCH
    if (hipMemsetAsync((unsigned char*)d_ws + WS_BAR, 0, XCD_BAR_WORDS * 4, stream) != hipSuccess) { fprintf(stderr, "memset failed\n"); return; }
    a.ph_lo = 0; a.ph_hi = 17;
    void* kargs[] = {&a};
    hipError_t e = hipLaunchCooperativeKernel((const void*)mk_fwd, dim3(grid), dim3(512), kargs, LDS_BYTES, stream);
    if (e != hipSuccess) fprintf(stderr, "cooperative launch failed: %s (grid %d)\n", hipGetErrorString(e), grid);
#else
    for (int ph = 0; ph < 17; ++ph) { a.ph_lo = ph; a.ph_hi = ph + 1; hipLaunchKernelGGL(mk_fwd, dim3(grid), dim3(512), LDS_BYTES, stream, a); }
#endif
}
```

```cpp
#include <hip/hip_runtime.h>
#include <hip/hip_cooperative_groups.h>
#include <cstdio>
#include <cstdint>
namespace cg = cooperative_groups;

#ifndef REP_PH
#define REP_PH -1
#endif
#ifndef REP_SUB
#define REP_SUB 7
#endif
#ifndef PERM_MASK
#define PERM_MASK 8
#endif
#ifndef MK_ONE_LAUNCH
#define MK_ONE_LAUNCH 1
#endif

#define LAS __attribute__((address_space(3)))
typedef unsigned short bf16_t;
typedef short bf16x8 __attribute__((ext_vector_type(8)));
typedef short s16x4 __attribute__((ext_vector_type(4)));
typedef float f32x4 __attribute__((ext_vector_type(4)));
typedef float f32x16 __attribute__((ext_vector_type(16)));
typedef unsigned u32x4 __attribute__((ext_vector_type(4)));
typedef unsigned u32x2 __attribute__((ext_vector_type(2)));

constexpr int DM = 1024, TP = 4112, NPR = 4 * TP, NSR = 512, MR = NPR + NSR, MP = 17152, DFF = 2816, NIN = 5632;
constexpr int LDV = 4160;
constexpr float RMS_EPS = 1e-6f;
constexpr float QSCALE = 0.125f * 1.4426950408889634f;
constexpr size_t OFF_YP = 0;
constexpr size_t OFF_YS = OFF_YP + (size_t)4 * 4096 * 1024;
constexpr size_t OFF_KP = OFF_YS + (size_t)512 * 1024;
constexpr size_t OFF_VP = OFF_KP + (size_t)2 * NPR * 512;
constexpr size_t OFF_PP = OFF_VP + (size_t)2 * NPR * 512;
constexpr size_t OFF_CP = OFF_PP + (size_t)2 * 4 * 15 * 256;
constexpr size_t OFF_KS = OFF_CP + (size_t)2 * 4 * 2 * 256;
constexpr size_t OFF_VS = OFF_KS + (size_t)2 * 512 * 512;
constexpr size_t OFF_PS = OFF_VS + (size_t)2 * 512 * 512;
constexpr size_t OFF_CS = OFF_PS + (size_t)2 * 32 * 15 * 256;
constexpr size_t OUT_TOTAL = OFF_CS + (size_t)2 * 32 * 2 * 256;
constexpr size_t MiB = 1u << 20;
constexpr size_t WS_RSS = 0;
constexpr size_t WS_BAR = 768 * 1024;
constexpr size_t WS_W = 1 * MiB;
constexpr size_t W_GU1 = 0, W_DN1 = W_GU1 + (size_t)NIN * DM * 2, W_IN = W_DN1 + (size_t)DM * DFF * 2, W_BR = W_IN + (size_t)NIN * DM * 2,
                 W_OUT = W_BR + (size_t)DM * DM * 2, W_GU2 = W_OUT + (size_t)DM * DM * 2, W_DN2 = W_GU2 + (size_t)NIN * DM * 2, W_LAYER = W_DN2 + (size_t)DM * DFF * 2;
static_assert(W_LAYER == 48 * MiB, "weights per layer");
constexpr size_t WS_XB = 97 * MiB;
constexpr size_t WS_HF = 131 * MiB;
constexpr size_t WS_ACT = 198 * MiB;
constexpr size_t WS_G = 198 * MiB;
constexpr size_t WS_PA = 299 * MiB;
constexpr size_t WS_MIXF = 299 * MiB;
constexpr size_t WS_MIXB = 366 * MiB;
constexpr size_t WS_Q = 366 * MiB;
constexpr size_t WS_KP = 383 * MiB;
constexpr size_t WS_VT = 400 * MiB;
constexpr size_t WS_PRE = 421 * MiB;
constexpr size_t WS_END = 455 * MiB;
static_assert(WS_XB + (size_t)MP * DM * 2 <= WS_HF && WS_HF + (size_t)MP * DM * 4 <= WS_ACT && WS_G + (size_t)MP * 3072 * 2 <= WS_PA && WS_PA + (size_t)MP * DM * 4 <= WS_Q &&
              WS_Q + (size_t)MP * 512 * 2 <= WS_KP && WS_KP + (size_t)(48 + MP) * 1024 <= WS_VT && WS_VT + (size_t)40 * 64 * LDV * 2 <= WS_PRE && WS_PRE + (size_t)MP * DM * 2 <= WS_END, "ws map");
constexpr int LDS_CTL = 8 * 16640;
constexpr int LDS_BYTES = LDS_CTL + 64;

struct Args { const float* in[26]; float* out; unsigned char* ws; int ph_lo, ph_hi; };

struct Ctx {
    const float* const* in;
    float* out; unsigned char* ws;
    float* RSS; bf16_t* XB; float* HF; bf16_t* ACT; bf16_t* G; float* PA; float* MIXF; bf16_t* PAB; bf16_t* MIXB; bf16_t* Q; bf16_t* KP; bf16_t* VT; bf16_t* VB; bf16_t* PRE;
};

__device__ __forceinline__ unsigned cvt_pk_bf16(float lo, float hi) { unsigned r; asm volatile("v_cvt_pk_bf16_f32 %0, %1, %2" : "=v"(r) : "v"(lo), "v"(hi)); return r; }
__device__ __forceinline__ u32x2 pk4(f32x4 v) { u32x2 r; r.x = cvt_pk_bf16(v[0], v[1]); r.y = cvt_pk_bf16(v[2], v[3]); return r; }
__device__ __forceinline__ float bf2f(unsigned short b) { return __uint_as_float(((unsigned)b) << 16); }
__device__ __forceinline__ f32x4 unpk4(u32x2 p) { f32x4 r; r[0] = __uint_as_float(p.x << 16); r[1] = __uint_as_float(p.x & 0xffff0000u); r[2] = __uint_as_float(p.y << 16); r[3] = __uint_as_float(p.y & 0xffff0000u); return r; }
__device__ __forceinline__ int opaque_tid() { int t = threadIdx.x; asm volatile("" : "+v"(t)); return t; }
__device__ __forceinline__ int opaque_bid() { int t = blockIdx.x; asm volatile("" : "+s"(t)); return t; }
__device__ __forceinline__ int crow(int r, int hi) { return (r & 3) + 8 * (r >> 2) + 4 * hi; }

namespace pg8 {
constexpr int BM = 256, BK = 64, HALF = 128, HTB = HALF * BK * 2, STAGE_BYTES = 8 * HTB, NXCD = 8, WGM = 8;
__host__ __device__ __forceinline__ int lds_byte(int r, int c) { const int st = (r >> 4) * 2 + (c >> 5), rr = r & 15, cc = c & 31, ob = rr * 64 + cc * 2; return st * 1024 + (ob ^ (((ob >> 9) & 1) << 5)); }
__host__ __device__ __forceinline__ void stage_rc(int b, int& R, int& C) { const int st = b / 1024, sb = b % 1024, swz = sb ^ (((sb >> 9) & 1) << 5); R = (st >> 1) * 16 + swz / 64; C = (st & 1) * 32 + (swz % 64) / 2; }

struct Unit { int pm, pn, kofs, nt, seg; };
struct Gemm { const bf16_t* A; const bf16_t* Bt; int lda, ldb; };
struct Sched {
    int nM, nN, nwg, G, c, segs, nt_full;
    __device__ bool next(int i, Unit& u) const {
        const int ti = (segs == 3) ? i / 3 : i; const int sg = (segs == 3) ? i - 3 * ti : 3;
        const long L = (long)ti * G + c; if (L >= nwg) return false;
        int wgid = (int)L; { const int q = nwg / NXCD, r = nwg % NXCD, xcd = wgid % NXCD, off = wgid / NXCD; wgid = (xcd < r ? xcd * (q + 1) : r * (q + 1) + (xcd - r) * q) + off; }
        const int nig = WGM * nN, gid = wgid / nig, fm = gid * WGM, gsz = (nM - fm) < WGM ? (nM - fm) : WGM;
        u.pm = fm + ((wgid % nig) % gsz); u.pn = (wgid % nig) / gsz;
        u.seg = sg;
        if (segs == 3) { u.kofs = sg == 0 ? 0 : (sg == 1 ? 256 : 512); u.nt = sg == 2 ? 8 : 4; }
        else { u.kofs = 0; u.nt = nt_full; }
        return true;
    }
};
enum { EK_SWIGLU = 0, EK_RESID = 1, EK_PROJ = 2, EK_BRANCH = 3 };
struct EpiDesc { int kind, l, final_; float alpha; const float* rss_in; float* rss_out; };

__device__ __forceinline__ float sigmoidf_(float v) { return __builtin_amdgcn_rcpf(1.f + __builtin_amdgcn_exp2f(-1.4426950408889634f * v)); }

template <int K>
__device__ __forceinline__ void epilogue(const f32x4 (&acc)[2][2][4][2], const Unit& u, const EpiDesc& E, const Ctx& C, int wr, int wc, int fr, int fq) {
    const int row0 = u.pm * 256 + wr * 64 + fr;
    const int lc0 = 32 * wc + 4 * fq;
    if (K == EK_SWIGLU || K == EK_PROJ) {
        float rstd[2][4];
#pragma unroll
        for (int ai = 0; ai < 2; ++ai)
#pragma unroll
            for (int m = 0; m < 4; ++m) rstd[ai][m] = E.rss_in[row0 + 128 * ai + 16 * m];
#pragma unroll
        for (int ai = 0; ai < 2; ++ai)
#pragma unroll
            for (int m = 0; m < 4; ++m) rstd[ai][m] = __builtin_amdgcn_rsqf(rstd[ai][m] * (1.f / 1024.f) + RMS_EPS);
        if (K == EK_SWIGLU) {
#pragma unroll
            for (int ai = 0; ai < 2; ++ai)
#pragma unroll
                for (int m = 0; m < 4; ++m) {
                    const int row = row0 + 128 * ai + 16 * m;
#pragma unroll
                    for (int bj = 0; bj < 2; ++bj) {
                        const f32x4 g = acc[ai][bj][m][0] * rstd[ai][m], up = acc[ai][bj][m][1] * rstd[ai][m];
                        f32x4 a;
#pragma unroll
                        for (int i = 0; i < 4; ++i) a[i] = g[i] * sigmoidf_(g[i]) * up[i];
                        const int j = 16 * (8 * u.pn + 4 * bj + wc) + 4 * fq;
                        *(u32x2*)(C.ACT + (size_t)row * DFF + j) = pk4(a);
                    }
                }
        } else {
            const int pn = u.pn, l = E.l;
            if (pn < 4) {
#pragma unroll
                for (int ai = 0; ai < 2; ++ai)
#pragma unroll
                    for (int m = 0; m < 4; ++m) {
                        const int row = row0 + 128 * ai + 16 * m;
#pragma unroll
                        for (int bj = 0; bj < 2; ++bj)
#pragma unroll
                            for (int n = 0; n < 2; ++n) *(u32x2*)(C.PAB + (size_t)row * DM + 256 * pn + 128 * bj + 16 * n + lc0) = pk4(acc[ai][bj][m][n] * rstd[ai][m]);
                    }
            } else if (pn < 8) {
                const bool isk = pn >= 6; const int head = 4 * (pn & 1) + wc;
                const float* gn = C.in[isk ? 19 : 18] + (size_t)l * 512 + 64 * head + 4 * fq;
                f32x4 gv[2][2];
#pragma unroll
                for (int bj = 0; bj < 2; ++bj)
#pragma unroll
                    for (int n = 0; n < 2; ++n) gv[bj][n] = *(const f32x4*)(gn + 32 * bj + 16 * n) * (isk ? 1.f : QSCALE);
#pragma unroll
                for (int ai = 0; ai < 2; ++ai)
#pragma unroll
                    for (int m = 0; m < 4; ++m) {
                        const int row = row0 + 128 * ai + 16 * m;
                        f32x4 v[2][2]; float ss = 0.f;
#pragma unroll
                        for (int bj = 0; bj < 2; ++bj)
#pragma unroll
                            for (int n = 0; n < 2; ++n) { v[bj][n] = acc[ai][bj][m][n] * rstd[ai][m]; ss += v[bj][n][0] * v[bj][n][0] + v[bj][n][1] * v[bj][n][1] + v[bj][n][2] * v[bj][n][2] + v[bj][n][3] * v[bj][n][3]; }
                        ss += __shfl_xor(ss, 16); ss += __shfl_xor(ss, 32);
                        const float rinv = __builtin_amdgcn_rsqf(ss * (1.f / 64.f) + RMS_EPS);
                        float* kdst = (float*)(C.PRE + (size_t)row * DM);
                        if (row < NPR) kdst = C.out + OFF_KP + ((size_t)l * NPR + row) * 512; else if (row < MR) kdst = C.out + OFF_KS + ((size_t)l * NSR + (row - NPR)) * 512;
                        bf16_t* bdst = (isk ? C.KP : C.Q) + (size_t)row * 512 + 64 * head + 4 * fq;
#pragma unroll
                        for (int bj = 0; bj < 2; ++bj)
#pragma unroll
                            for (int n = 0; n < 2; ++n) {
                                const int d = 32 * bj + 16 * n;
                                const f32x4 o = v[bj][n] * rinv * gv[bj][n];
                                *(u32x2*)(bdst + d) = pk4(o);
                                if (isk) *(f32x4*)(kdst + 64 * head + 4 * fq + d) = o;
                            }
                    }
            } else if (pn < 10) {
#pragma unroll
                for (int ai = 0; ai < 2; ++ai)
#pragma unroll
                    for (int m = 0; m < 4; ++m) {
                        const int row = row0 + 128 * ai + 16 * m;
                        float* vdst = (float*)(C.PRE + (size_t)row * DM);
                        if (row < NPR) vdst = C.out + OFF_VP + ((size_t)l * NPR + row) * 512; else if (row < MR) vdst = C.out + OFF_VS + ((size_t)l * NSR + (row - NPR)) * 512;
#pragma unroll
                        for (int bj = 0; bj < 2; ++bj)
#pragma unroll
                            for (int n = 0; n < 2; ++n) {
                                const int c512 = 256 * (pn - 8) + 128 * bj + 16 * n + lc0;
                                const f32x4 o = acc[ai][bj][m][n] * rstd[ai][m];
                                *(f32x4*)(vdst + c512) = o;
                                *(u32x2*)(C.VB + (size_t)row * 512 + c512) = pk4(o);
                            }
                    }
            } else {
                const int br = (pn - 10) >> 2, cb = 256 * ((pn - 10) & 3);
#pragma unroll
                for (int ai = 0; ai < 2; ++ai)
#pragma unroll
                    for (int m = 0; m < 4; ++m) {
                        const int row = row0 + 128 * ai + 16 * m;
#pragma unroll
                        for (int bj = 0; bj < 2; ++bj)
#pragma unroll
                            for (int n = 0; n < 2; ++n) {
                                const f32x4 x = acc[ai][bj][m][n] * rstd[ai][m]; f32x4 sg;
#pragma unroll
                                for (int i = 0; i < 4; ++i) sg[i] = fmaxf(sigmoidf_(x[i]), 1e-30f);
                                *(u32x2*)(C.G + (size_t)row * 3072 + br * 1024 + cb + 128 * bj + 16 * n + lc0) = pk4(sg);
                            }
                    }
            }
        }
    } else if (K == EK_RESID) {
#pragma unroll
        for (int ai = 0; ai < 2; ++ai)
#pragma unroll
        for (int mh = 0; mh < 2; ++mh) {
            u32x2 h[2][2][2];
#pragma unroll
            for (int m2 = 0; m2 < 2; ++m2)
#pragma unroll
                for (int bj = 0; bj < 2; ++bj)
#pragma unroll
                    for (int n = 0; n < 2; ++n) h[m2][bj][n] = *(const u32x2*)(C.XB + (size_t)(row0 + 128 * ai + 16 * (2 * mh + m2)) * DM + 256 * u.pn + 128 * bj + 16 * n + lc0);
#pragma unroll
            for (int m2 = 0; m2 < 2; ++m2) {
                const int m = 2 * mh + m2;
                const int row = row0 + 128 * ai + 16 * m;
                float* dst = C.PA + (size_t)row * DM;
                if (E.final_) {
                    if (row < NPR) { const int b = row / TP, t = row - b * TP; if (t >= 16) dst = C.out + OFF_YP + ((size_t)b * 4096 + (t - 16)) * 1024; }
                    else if (row < MR) dst = C.out + OFF_YS + (size_t)(row - NPR) * 1024;
                }
                float ss = 0.f;
#pragma unroll
                for (int bj = 0; bj < 2; ++bj)
#pragma unroll
                    for (int n = 0; n < 2; ++n) {
                        const int col = 256 * u.pn + 128 * bj + 16 * n + lc0;
                        const f32x4 hv = unpk4(h[m2][bj][n]) + acc[ai][bj][m][n] * E.alpha;
                        if (E.final_) *(f32x4*)(dst + col) = hv;
                        else {
                            *(u32x2*)(C.XB + (size_t)row * DM + col) = pk4(hv);
                            ss += hv[0] * hv[0] + hv[1] * hv[1] + hv[2] * hv[2] + hv[3] * hv[3];
                        }
                    }
                if (!E.final_) {
                    ss += __shfl_xor(ss, 16); ss += __shfl_xor(ss, 32);
                    if (fq == 0) unsafeAtomicAdd(E.rss_out + row, ss);
                }
            }
        }
    } else {
        const int seg = u.seg;
#pragma unroll
        for (int ai = 0; ai < 2; ++ai)
#pragma unroll
        for (int mh = 0; mh < 2; ++mh) {
            u32x2 gq[2][2][2], mf[2][2][2];
#pragma unroll
            for (int m2 = 0; m2 < 2; ++m2)
#pragma unroll
                for (int bj = 0; bj < 2; ++bj)
#pragma unroll
                    for (int n = 0; n < 2; ++n) {
                        const int row = row0 + 128 * ai + 16 * (2 * mh + m2), col = 256 * u.pn + 128 * bj + 16 * n + lc0;
                        gq[m2][bj][n] = *(const u32x2*)(C.G + (size_t)row * 3072 + seg * 1024 + col);
                        if (seg > 0) mf[m2][bj][n] = *(const u32x2*)(C.MIXB + (size_t)row * DM + col); else mf[m2][bj][n] = (u32x2){0u, 0u};
                    }
#pragma unroll
            for (int m2 = 0; m2 < 2; ++m2)
#pragma unroll
                for (int bj = 0; bj < 2; ++bj)
#pragma unroll
                    for (int n = 0; n < 2; ++n) {
                        const int row = row0 + 128 * ai + 16 * (2 * mh + m2), col = 256 * u.pn + 128 * bj + 16 * n + lc0;
                        const f32x4 r = acc[ai][bj][2 * mh + m2][n] * unpk4(gq[m2][bj][n]) + unpk4(mf[m2][bj][n]);
                        *(u32x2*)(C.MIXB + (size_t)row * DM + col) = pk4(r);
                    }
        }
    }
}

__host__ __device__ __forceinline__ int perm32(int rho) { const int n = rho >> 4, i = rho & 15; return 8 * (i >> 2) + 4 * n + (i & 3); }
__device__ __forceinline__ u32x4 pk8(f32x4 a, f32x4 b) { const u32x2 p = pk4(a), q = pk4(b); return (u32x4){p.x, p.y, q.x, q.y}; }
template <int K>
__device__ __forceinline__ void epilogue_p(const f32x4 (&acc)[2][2][4][2], const Unit& u, const EpiDesc& E, const Ctx& C, int wr, int wc, int fr, int fq) {
    const int row0 = u.pm * 256 + wr * 64 + fr;
    const int lc8 = 32 * wc + 8 * fq;
    if (K == EK_SWIGLU || K == EK_PROJ) {
        float rstd[2][4];
#pragma unroll
        for (int ai = 0; ai < 2; ++ai)
#pragma unroll
            for (int m = 0; m < 4; ++m) rstd[ai][m] = E.rss_in[row0 + 128 * ai + 16 * m];
#pragma unroll
        for (int ai = 0; ai < 2; ++ai)
#pragma unroll
            for (int m = 0; m < 4; ++m) rstd[ai][m] = __builtin_amdgcn_rsqf(rstd[ai][m] * (1.f / 1024.f) + RMS_EPS);
        if (K == EK_SWIGLU) {
#pragma unroll
            for (int ai = 0; ai < 2; ++ai)
#pragma unroll
                for (int m = 0; m < 4; ++m) {
                    const int row = row0 + 128 * ai + 16 * m;
                    f32x4 a[2];
#pragma unroll
                    for (int n = 0; n < 2; ++n) {
                        const f32x4 g = acc[ai][0][m][n] * rstd[ai][m], up = acc[ai][1][m][n] * rstd[ai][m];
#pragma unroll
                        for (int i = 0; i < 4; ++i) a[n][i] = g[i] * sigmoidf_(g[i]) * up[i];
                    }
                    *(u32x4*)(C.ACT + (size_t)row * DFF + 128 * u.pn + lc8) = pk8(a[0], a[1]);
                }
        } else {
            const int pn = u.pn, l = E.l;
            if (pn < 4) {
#pragma unroll
                for (int ai = 0; ai < 2; ++ai)
#pragma unroll
                    for (int m = 0; m < 4; ++m) {
                        const int row = row0 + 128 * ai + 16 * m;
#pragma unroll
                        for (int bj = 0; bj < 2; ++bj) *(u32x4*)(C.PAB + (size_t)row * DM + 256 * pn + 128 * bj + lc8) = pk8(acc[ai][bj][m][0] * rstd[ai][m], acc[ai][bj][m][1] * rstd[ai][m]);
                    }
            } else if (pn < 8) {
                const bool isk = pn >= 6; const int head = 4 * (pn & 1) + wc;
                const float* gn = C.in[isk ? 19 : 18] + (size_t)l * 512 + 64 * head + 8 * fq;
                f32x4 gv[2][2];
#pragma unroll
                for (int bj = 0; bj < 2; ++bj)
#pragma unroll
                    for (int n = 0; n < 2; ++n) gv[bj][n] = *(const f32x4*)(gn + 32 * bj + 4 * n) * (isk ? 1.f : QSCALE);
#pragma unroll
                for (int ai = 0; ai < 2; ++ai)
#pragma unroll
                    for (int m = 0; m < 4; ++m) {
                        const int row = row0 + 128 * ai + 16 * m;
                        f32x4 v[2][2]; float ss = 0.f;
#pragma unroll
                        for (int bj = 0; bj < 2; ++bj)
#pragma unroll
                            for (int n = 0; n < 2; ++n) { v[bj][n] = acc[ai][bj][m][n] * rstd[ai][m]; ss += v[bj][n][0] * v[bj][n][0] + v[bj][n][1] * v[bj][n][1] + v[bj][n][2] * v[bj][n][2] + v[bj][n][3] * v[bj][n][3]; }
                        ss += __shfl_xor(ss, 16); ss += __shfl_xor(ss, 32);
                        const float rinv = __builtin_amdgcn_rsqf(ss * (1.f / 64.f) + RMS_EPS);
                        float* kdst = (float*)(C.PRE + (size_t)row * DM);
                        if (row < NPR) kdst = C.out + OFF_KP + ((size_t)l * NPR + row) * 512; else if (row < MR) kdst = C.out + OFF_KS + ((size_t)l * NSR + (row - NPR)) * 512;
                        bf16_t* bdst = (isk ? C.KP : C.Q) + (size_t)row * 512 + 64 * head + 8 * fq;
#pragma unroll
                        for (int bj = 0; bj < 2; ++bj) {
                            const f32x4 o0 = v[bj][0] * rinv * gv[bj][0], o1 = v[bj][1] * rinv * gv[bj][1];
                            *(u32x4*)(bdst + 32 * bj) = pk8(o0, o1);
                            if (isk) { *(f32x4*)(kdst + 64 * head + 8 * fq + 32 * bj) = o0; *(f32x4*)(kdst + 64 * head + 8 * fq + 32 * bj + 4) = o1; }
                        }
                    }
            } else if (pn < 10) {
#pragma unroll
                for (int ai = 0; ai < 2; ++ai)
#pragma unroll
                    for (int m = 0; m < 4; ++m) {
                        const int row = row0 + 128 * ai + 16 * m;
                        float* vdst = (float*)(C.PRE + (size_t)row * DM);
                        if (row < NPR) vdst = C.out + OFF_VP + ((size_t)l * NPR + row) * 512; else if (row < MR) vdst = C.out + OFF_VS + ((size_t)l * NSR + (row - NPR)) * 512;
                        const int b = row / TP, t = row - b * TP;
                        bf16_t* vt = C.VT + (size_t)b * 512 * LDV + 48 + t;
#pragma unroll
                        for (int bj = 0; bj < 2; ++bj)
#pragma unroll
                            for (int n = 0; n < 2; ++n) {
                                const int c512 = 256 * (pn - 8) + 128 * bj + lc8 + 4 * n;
                                const f32x4 o = acc[ai][bj][m][n] * rstd[ai][m];
                                *(f32x4*)(vdst + c512) = o;
                                const u32x2 p = pk4(o);
                                vt[(size_t)(c512 + 0) * LDV] = (bf16_t)(p.x & 0xffffu); vt[(size_t)(c512 + 1) * LDV] = (bf16_t)(p.x >> 16);
                                vt[(size_t)(c512 + 2) * LDV] = (bf16_t)(p.y & 0xffffu); vt[(size_t)(c512 + 3) * LDV] = (bf16_t)(p.y >> 16);
                            }
                    }
            } else {
                const int br = (pn - 10) >> 2, cb = 256 * ((pn - 10) & 3);
#pragma unroll
                for (int ai = 0; ai < 2; ++ai)
#pragma unroll
                    for (int m = 0; m < 4; ++m) {
                        const int row = row0 + 128 * ai + 16 * m;
#pragma unroll
                        for (int bj = 0; bj < 2; ++bj) {
                            f32x4 sg[2];
#pragma unroll
                            for (int n = 0; n < 2; ++n) {
                                const f32x4 x = acc[ai][bj][m][n] * rstd[ai][m];
#pragma unroll
                                for (int i = 0; i < 4; ++i) sg[n][i] = sigmoidf_(x[i]);
                            }
                            *(u32x4*)(C.G + (size_t)row * 3072 + br * 1024 + cb + 128 * bj + lc8) = pk8(sg[0], sg[1]);
                        }
                    }
            }
        }
    } else if (K == EK_RESID) {
#pragma unroll
        for (int ai = 0; ai < 2; ++ai)
#pragma unroll
        for (int mh = 0; mh < 2; ++mh) {
            u32x4 h[2][2];
#pragma unroll
            for (int m2 = 0; m2 < 2; ++m2)
#pragma unroll
                for (int bj = 0; bj < 2; ++bj) h[m2][bj] = *(const u32x4*)(C.XB + (size_t)(row0 + 128 * ai + 16 * (2 * mh + m2)) * DM + 256 * u.pn + 128 * bj + lc8);
#pragma unroll
            for (int m2 = 0; m2 < 2; ++m2) {
                const int m = 2 * mh + m2;
                const int row = row0 + 128 * ai + 16 * m;
                float* dst = C.PA + (size_t)row * DM;
                if (E.final_) {
                    if (row < NPR) { const int b = row / TP, t = row - b * TP; if (t >= 16) dst = C.out + OFF_YP + ((size_t)b * 4096 + (t - 16)) * 1024; }
                    else if (row < MR) dst = C.out + OFF_YS + (size_t)(row - NPR) * 1024;
                }
                float ss = 0.f;
#pragma unroll
                for (int bj = 0; bj < 2; ++bj) {
                    const int col = 256 * u.pn + 128 * bj + lc8;
                    const f32x4 hv0 = unpk4((u32x2){h[m2][bj].x, h[m2][bj].y}) + acc[ai][bj][m][0] * E.alpha, hv1 = unpk4((u32x2){h[m2][bj].z, h[m2][bj].w}) + acc[ai][bj][m][1] * E.alpha;
                    if (E.final_) { *(f32x4*)(dst + col) = hv0; *(f32x4*)(dst + col + 4) = hv1; }
                    else {
                        *(u32x4*)(C.XB + (size_t)row * DM + col) = pk8(hv0, hv1);
                        ss += hv0[0] * hv0[0] + hv0[1] * hv0[1] + hv0[2] * hv0[2] + hv0[3] * hv0[3] + hv1[0] * hv1[0] + hv1[1] * hv1[1] + hv1[2] * hv1[2] + hv1[3] * hv1[3];
                    }
                }
                if (!E.final_) {
                    ss += __shfl_xor(ss, 16); ss += __shfl_xor(ss, 32);
                    if (fq == 0) unsafeAtomicAdd(E.rss_out + row, ss);
                }
            }
        }
    } else {
        const int seg = u.seg;
#pragma unroll
        for (int ai = 0; ai < 2; ++ai)
#pragma unroll
        for (int mh = 0; mh < 2; ++mh) {
            u32x4 gq[2][2], mf[2][2];
#pragma unroll
            for (int m2 = 0; m2 < 2; ++m2)
#pragma unroll
                for (int bj = 0; bj < 2; ++bj) {
                    const int row = row0 + 128 * ai + 16 * (2 * mh + m2), col = 256 * u.pn + 128 * bj + lc8;
                    gq[m2][bj] = *(const u32x4*)(C.G + (size_t)row * 3072 + seg * 1024 + col);
                    if (seg > 0) mf[m2][bj] = *(const u32x4*)(C.MIXB + (size_t)row * DM + col); else mf[m2][bj] = (u32x4){0u, 0u, 0u, 0u};
                }
#pragma unroll
            for (int m2 = 0; m2 < 2; ++m2)
#pragma unroll
                for (int bj = 0; bj < 2; ++bj) {
                    const int m = 2 * mh + m2;
                    const int row = row0 + 128 * ai + 16 * m, col = 256 * u.pn + 128 * bj + lc8;
                    const f32x4 r0 = acc[ai][bj][m][0] * unpk4((u32x2){gq[m2][bj].x, gq[m2][bj].y}) + unpk4((u32x2){mf[m2][bj].x, mf[m2][bj].y});
                    const f32x4 r1 = acc[ai][bj][m][1] * unpk4((u32x2){gq[m2][bj].z, gq[m2][bj].w}) + unpk4((u32x2){mf[m2][bj].z, mf[m2][bj].w});
                    *(u32x4*)(C.MIXB + (size_t)row * DM + col) = pk8(r0, r1);
                }
        }
    }
}

template <bool PERM>
__device__ __forceinline__ void gemm_phase(LAS unsigned char* lds, const Gemm g, const Sched& S, const EpiDesc& E, const Ctx& C) {
    const int tid = opaque_tid(), wid = __builtin_amdgcn_readfirstlane(tid >> 6), lane = tid & 63, wr = wid >> 2, wc = wid & 3, fr = lane & 15, fq = lane >> 4;
    unsigned voffA[2], voffB[2];
#pragma unroll
    for (int i = 0; i < 2; ++i) { int R, Cc; stage_rc(tid * 16 + i * 8192, R, Cc); const int Rb = PERM ? (R & ~31) + perm32(R & 31) : R; voffA[i] = (unsigned)(R * g.lda + Cc) * 2u; voffB[i] = (unsigned)(Rb * g.ldb + Cc) * 2u; }
    const size_t kstep = (size_t)(BK * 2);
    const size_t hstepA = (size_t)HALF * g.lda * 2, hstepB = (size_t)HALF * g.ldb * 2;
    const size_t tstepA = 2 * hstepA, tstepB = 2 * hstepB;
    const unsigned ldsw = (unsigned)wid * 1024u;
    const int aoff = lds_byte(wr * 64 + fr, fq * 8), boff = lds_byte(wc * 32 + fr, fq * 8);
#define PG8_SA(b, h) (((b) * 2 + (h)) * HTB)
#define PG8_SB(b, h) ((4 + (b) * 2 + (h)) * HTB)
#define PG8_STAGE(bufoff, gbase, voff) do { _Pragma("unroll") for (int _i = 0; _i < 2; ++_i) \
        __builtin_amdgcn_global_load_lds((const unsigned*)((const char*)(gbase) + (voff)[_i]), (LAS unsigned*)(lds + (bufoff) + ldsw + _i * 8192), 16, 0, 0); } while (0)
#define PG8_LDA(dst, b, h) do { _Pragma("unroll") for (int m = 0; m < 4; ++m) _Pragma("unroll") for (int k = 0; k < 2; ++k) dst[m][k] = *(const LAS bf16x8*)(lds + PG8_SA(b, h) + aoff + m * 2048 + k * 1024); } while (0)
#define PG8_LDB(dst, b, h) do { _Pragma("unroll") for (int n = 0; n < 2; ++n) _Pragma("unroll") for (int k = 0; k < 2; ++k) dst[n][k] = *(const LAS bf16x8*)(lds + PG8_SB(b, h) + boff + n * 2048 + k * 1024); } while (0)
#define PG8_MMA(ai, bj, At, Bt) do { __builtin_amdgcn_s_setprio(1); _Pragma("unroll") for (int m = 0; m < 4; ++m) _Pragma("unroll") for (int n = 0; n < 2; ++n) _Pragma("unroll") for (int k = 0; k < 2; ++k) \
        acc[ai][bj][m][n] = __builtin_amdgcn_mfma_f32_16x16x32_bf16(Bt[n][k], At[m][k], acc[ai][bj][m][n], 0, 0, 0); __builtin_amdgcn_s_setprio(0); } while (0)
#define PG8_WAIT_V(n) asm volatile("s_waitcnt vmcnt(" #n ")" ::: "memory")
#define PG8_WAIT_L(n) asm volatile("s_waitcnt lgkmcnt(" #n ")" ::: "memory")
#define PG8_BAR __builtin_amdgcn_s_barrier()
#define PG8_SCHED __builtin_amdgcn_sched_barrier(0)
    Unit cur, nxt; int ui = 0;
    if (!S.next(0, cur)) return;
    f32x4 acc[2][2][4][2];
#pragma unroll
    for (int a = 0; a < 2; ++a)
#pragma unroll
        for (int b = 0; b < 2; ++b)
#pragma unroll
            for (int m = 0; m < 4; ++m)
#pragma unroll
                for (int n = 0; n < 2; ++n) acc[a][b][m][n] = (f32x4){0.f, 0.f, 0.f, 0.f};
    bf16x8 At[4][2], B0[2][2], B1[2][2];
    const char* cA = (const char*)g.A + (size_t)cur.pm * tstepA + (size_t)cur.kofs * 2; const char* cB = (const char*)g.Bt + (size_t)cur.pn * tstepB + (size_t)cur.kofs * 2;
    PG8_STAGE(PG8_SB(0, 0), cB, voffB); PG8_STAGE(PG8_SB(0, 1), cB + hstepB, voffB); PG8_STAGE(PG8_SA(0, 0), cA, voffA); PG8_STAGE(PG8_SA(0, 1), cA + hstepA, voffA);
    if (wr == 1) PG8_BAR;
    PG8_WAIT_V(2); PG8_BAR;
    PG8_STAGE(PG8_SB(1, 0), cB + kstep, voffB); PG8_STAGE(PG8_SA(1, 0), cA + kstep, voffA); PG8_STAGE(PG8_SB(1, 1), cB + hstepB + kstep, voffB);
    PG8_WAIT_V(6); PG8_BAR;
    for (;;) {
        const bool has_next = S.next(ui + 1, nxt);
        const char* nA = has_next ? (const char*)g.A + (size_t)nxt.pm * tstepA + (size_t)nxt.kofs * 2 : cA; const char* nB = has_next ? (const char*)g.Bt + (size_t)nxt.pn * tstepB + (size_t)nxt.kofs * 2 : cB;
        const int nt = cur.nt;
        for (int t = 0; t < nt; t += 2) {
            const bool last = (t == nt - 2);
            const char* a1 = cA + (size_t)(t + 1) * kstep;
            const char* a2 = last ? nA : cA + (size_t)(t + 2) * kstep; const char* b2 = last ? nB : cB + (size_t)(t + 2) * kstep;
            const char* a3 = a2 + kstep; const char* b3 = b2 + kstep;
            PG8_LDB(B0, 0, 0); PG8_LDB(B1, 0, 1); PG8_SCHED; PG8_LDA(At, 0, 0); PG8_STAGE(PG8_SA(1, 1), a1 + hstepA, voffA);
            PG8_WAIT_V(8); PG8_WAIT_L(0); PG8_BAR; PG8_MMA(0, 0, At, B0); PG8_MMA(0, 1, At, B1); PG8_BAR; PG8_SCHED;
            PG8_LDA(At, 0, 1); PG8_STAGE(PG8_SB(0, 0), b2, voffB); PG8_STAGE(PG8_SB(0, 1), b2 + hstepB, voffB); PG8_STAGE(PG8_SA(0, 0), a2, voffA);
            PG8_WAIT_V(8); PG8_WAIT_L(0); PG8_BAR; PG8_MMA(1, 0, At, B0); PG8_MMA(1, 1, At, B1); PG8_BAR; PG8_SCHED;
            PG8_LDB(B0, 1, 0); PG8_LDB(B1, 1, 1); PG8_SCHED; PG8_LDA(At, 1, 0); PG8_STAGE(PG8_SA(0, 1), a2 + hstepA, voffA);
            PG8_WAIT_V(8); PG8_WAIT_L(0); PG8_BAR; PG8_MMA(0, 0, At, B0); PG8_MMA(0, 1, At, B1); PG8_BAR; PG8_SCHED;
            PG8_LDA(At, 1, 1); PG8_STAGE(PG8_SB(1, 0), b3, voffB); PG8_STAGE(PG8_SB(1, 1), b3 + hstepB, voffB); PG8_STAGE(PG8_SA(1, 0), a3, voffA);
            PG8_WAIT_V(8); PG8_WAIT_L(0); PG8_BAR; PG8_MMA(1, 0, At, B0); PG8_MMA(1, 1, At, B1); PG8_BAR; PG8_SCHED;
        }
        if (wr == 0) PG8_BAR;
        if (PERM) {
            if ((PERM_MASK & 1) && E.kind == EK_SWIGLU) epilogue_p<EK_SWIGLU>(acc, cur, E, C, wr, wc, fr, fq);
            else if ((PERM_MASK & 2) && E.kind == EK_RESID) epilogue_p<EK_RESID>(acc, cur, E, C, wr, wc, fr, fq);
            else if ((PERM_MASK & 4) && E.kind == EK_PROJ) epilogue_p<EK_PROJ>(acc, cur, E, C, wr, wc, fr, fq);
            else if ((PERM_MASK & 8) && E.kind == EK_BRANCH) epilogue_p<EK_BRANCH>(acc, cur, E, C, wr, wc, fr, fq);
        } else {
            if (!(PERM_MASK & 1) && E.kind == EK_SWIGLU) epilogue<EK_SWIGLU>(acc, cur, E, C, wr, wc, fr, fq);
            else if (!(PERM_MASK & 2) && E.kind == EK_RESID) epilogue<EK_RESID>(acc, cur, E, C, wr, wc, fr, fq);
            else if (!(PERM_MASK & 4) && E.kind == EK_PROJ) epilogue<EK_PROJ>(acc, cur, E, C, wr, wc, fr, fq);
            else if (!(PERM_MASK & 8) && E.kind == EK_BRANCH) epilogue<EK_BRANCH>(acc, cur, E, C, wr, wc, fr, fq);
        }
        if (!has_next) break;
#pragma unroll
        for (int a = 0; a < 2; ++a)
#pragma unroll
            for (int b = 0; b < 2; ++b)
#pragma unroll
                for (int m = 0; m < 4; ++m)
#pragma unroll
                    for (int n = 0; n < 2; ++n) acc[a][b][m][n] = (f32x4){0.f, 0.f, 0.f, 0.f};
        cur = nxt; cA = nA; cB = nB; ++ui;
        if (wr == 1) PG8_BAR;
    }
    PG8_WAIT_V(0);
    PG8_BAR;
#undef PG8_SA
#undef PG8_SB
#undef PG8_STAGE
#undef PG8_LDA
#undef PG8_LDB
#undef PG8_MMA
#undef PG8_WAIT_V
#undef PG8_WAIT_L
#undef PG8_BAR
#undef PG8_SCHED
}
__device__ __forceinline__ void small_unit(const Gemm g, const EpiDesc& E, const Ctx& C, int su, unsigned char* shm) {
    const int tid = opaque_tid(), lane = tid & 63, w = __builtin_amdgcn_readfirstlane(tid >> 6), m = lane & 31, hi = lane >> 5;
    const int row0 = 16384 + 64 * (su >> 4), col0 = 64 * (su & 15);
    int k_lo, k_len;
    if (E.kind == EK_BRANCH) { k_len = 128; k_lo = 128 * w; }
    else { k_len = (E.kind == EK_RESID && g.lda == DFF) ? DFF / 8 : DM / 8; k_lo = k_len * w; }
    const bf16_t* ap = g.A + (size_t)(row0 + m) * g.lda + k_lo + 8 * hi;
    const bf16_t* bp = g.Bt + (size_t)(col0 + m) * g.ldb + k_lo + 8 * hi;
    const size_t a32 = (size_t)32 * g.lda, b32 = (size_t)32 * g.ldb;
    f32x16 acc[2][2];
#pragma unroll
    for (int i = 0; i < 2; ++i)
#pragma unroll
        for (int j = 0; j < 2; ++j)
#pragma unroll
            for (int r = 0; r < 16; ++r) acc[i][j][r] = 0.f;
    const int nsteps = k_len >> 5;
    for (int s0 = 0; s0 < nsteps; s0 += 4) {
        bf16x8 fa[4][4], fb[4][4];
#pragma unroll
        for (int u = 0; u < 4; ++u) {
            const int k = 32 * min(s0 + u, nsteps - 1);
            fa[u][0] = *(const bf16x8*)(ap + k); fa[u][1] = *(const bf16x8*)(ap + a32 + k); fa[u][2] = *(const bf16x8*)(ap + k + 16); fa[u][3] = *(const bf16x8*)(ap + a32 + k + 16);
            fb[u][0] = *(const bf16x8*)(bp + k); fb[u][1] = *(const bf16x8*)(bp + b32 + k); fb[u][2] = *(const bf16x8*)(bp + k + 16); fb[u][3] = *(const bf16x8*)(bp + b32 + k + 16);
        }
#pragma unroll
        for (int u = 0; u < 4; ++u) {
            if (s0 + u < nsteps) {
                acc[0][0] = __builtin_amdgcn_mfma_f32_32x32x16_bf16(fa[u][0], fb[u][0], acc[0][0], 0, 0, 0); acc[0][1] = __builtin_amdgcn_mfma_f32_32x32x16_bf16(fa[u][0], fb[u][1], acc[0][1], 0, 0, 0);
                acc[1][0] = __builtin_amdgcn_mfma_f32_32x32x16_bf16(fa[u][1], fb[u][0], acc[1][0], 0, 0, 0); acc[1][1] = __builtin_amdgcn_mfma_f32_32x32x16_bf16(fa[u][1], fb[u][1], acc[1][1], 0, 0, 0);
                acc[0][0] = __builtin_amdgcn_mfma_f32_32x32x16_bf16(fa[u][2], fb[u][2], acc[0][0], 0, 0, 0); acc[0][1] = __builtin_amdgcn_mfma_f32_32x32x16_bf16(fa[u][2], fb[u][3], acc[0][1], 0, 0, 0);
                acc[1][0] = __builtin_amdgcn_mfma_f32_32x32x16_bf16(fa[u][3], fb[u][2], acc[1][0], 0, 0, 0); acc[1][1] = __builtin_amdgcn_mfma_f32_32x32x16_bf16(fa[u][3], fb[u][3], acc[1][1], 0, 0, 0);
            }
        }
    }
    float* P = (float*)shm + w * 4096;
#pragma unroll
    for (int i = 0; i < 2; ++i)
#pragma unroll
        for (int j = 0; j < 2; ++j)
#pragma unroll
            for (int r = 0; r < 16; ++r) P[(32 * i + crow(r, hi)) * 64 + 32 * j + m] = acc[i][j][r];
    __syncthreads();
    {
        const int r = tid >> 3, cg8 = (tid & 7) * 8, row = row0 + r, col = col0 + cg8;
        const float* pp = (const float*)shm + r * 64 + cg8;
        f32x4 v0, v1;
        if (E.kind == EK_BRANCH) {
            const bf16_t* gp = C.G + (size_t)row * 3072 + col;
            f32x4 s0 = *(const f32x4*)(pp) + *(const f32x4*)(pp + 4096), s1 = *(const f32x4*)(pp + 4) + *(const f32x4*)(pp + 4096 + 4);
            f32x4 t0 = *(const f32x4*)(pp + 2 * 4096) + *(const f32x4*)(pp + 3 * 4096), t1 = *(const f32x4*)(pp + 2 * 4096 + 4) + *(const f32x4*)(pp + 3 * 4096 + 4);
            f32x4 u0 = (*(const f32x4*)(pp + 4 * 4096) + *(const f32x4*)(pp + 5 * 4096)) + (*(const f32x4*)(pp + 6 * 4096) + *(const f32x4*)(pp + 7 * 4096));
            f32x4 u1 = (*(const f32x4*)(pp + 4 * 4096 + 4) + *(const f32x4*)(pp + 5 * 4096 + 4)) + (*(const f32x4*)(pp + 6 * 4096 + 4) + *(const f32x4*)(pp + 7 * 4096 + 4));
            const u32x4 ga = *(const u32x4*)(gp), gb = *(const u32x4*)(gp + 1024), gc = *(const u32x4*)(gp + 2048);
            v0 = s0 * unpk4((u32x2){ga.x, ga.y}) + t0 * unpk4((u32x2){gb.x, gb.y}) + u0 * unpk4((u32x2){gc.x, gc.y});
            v1 = s1 * unpk4((u32x2){ga.z, ga.w}) + t1 * unpk4((u32x2){gb.z, gb.w}) + u1 * unpk4((u32x2){gc.z, gc.w});
            const u32x2 p0 = pk4(v0), p1 = pk4(v1);
            *(u32x4*)(C.MIXB + (size_t)row * DM + col) = (u32x4){p0.x, p0.y, p1.x, p1.y};
        } else {
            v0 = (f32x4){0.f, 0.f, 0.f, 0.f}; v1 = v0;
#pragma unroll
            for (int ww = 0; ww < 8; ++ww) { v0 = v0 + *(const f32x4*)(pp + ww * 4096); v1 = v1 + *(const f32x4*)(pp + ww * 4096 + 4); }
            const u32x4 hb = *(const u32x4*)(C.XB + (size_t)row * DM + col);
            const f32x4 h0 = unpk4((u32x2){hb.x, hb.y}) + v0 * E.alpha, h1 = unpk4((u32x2){hb.z, hb.w}) + v1 * E.alpha;
            const u32x2 p0 = pk4(h0), p1 = pk4(h1);
            if (!E.final_) *(u32x4*)(C.XB + (size_t)row * DM + col) = (u32x4){p0.x, p0.y, p1.x, p1.y};
            if (E.final_) {
                float* dst = nullptr;
                if (row < NPR) { const int b = row / TP, t = row - b * TP; if (t >= 16) dst = C.out + OFF_YP + ((size_t)b * 4096 + (t - 16)) * 1024; }
                else dst = C.out + OFF_YS + (size_t)(row - NPR) * 1024;
                if (dst) { *(f32x4*)(dst + col) = h0; *(f32x4*)(dst + col + 4) = h1; }
            }
            float ss = h0[0] * h0[0] + h0[1] * h0[1] + h0[2] * h0[2] + h0[3] * h0[3] + h1[0] * h1[0] + h1[1] * h1[1] + h1[2] * h1[2] + h1[3] * h1[3];
            ss += __shfl_xor(ss, 1); ss += __shfl_xor(ss, 2); ss += __shfl_xor(ss, 4);
            if ((tid & 7) == 0) unsafeAtomicAdd(E.rss_out + row, ss);
        }
    }
    __syncthreads();
}
}

__device__ __forceinline__ float wave_sum(float v) {
#pragma unroll
    for (int o = 1; o < 64; o <<= 1) v += __shfl_xor(v, o);
    return v;
}
__device__ __forceinline__ const float* src_col(int kind, const float* W, const float* W2, int c) {
    if (kind == 1) { if (PERM_MASK & 1) { const int pn = c >> 8, sl = c & 255; return ((sl >> 7) ? W2 : W) + 128 * pn + (sl & 127); } const int Gc = c >> 5, n = (c >> 4) & 1, i = c & 15; return (n ? W2 : W) + 16 * Gc + i; }
    if (kind == 2) { const int pn = c >> 8; if (pn >= 4 && pn < 8) { const int s = c & 255, hl = (s >> 5) & 3, d = 32 * (s >> 7) + (s & 31); return W + 256 * pn + 64 * hl + d; } return W + c; }
    return W + c;
}
struct ItemP { const float* p; const float* gain; bf16_t* wt; int srcN, ldt, k0; };
__device__ __forceinline__ void item_set(ItemP& P, int kind, const float* W, const float* W2, int srcN, const float* gain, bf16_t* WT, int ldt, int kb, int cb, int lane) {
    const int k0 = 64 * kb, c0 = 64 * cb, c4 = (lane & 15) * 4, kr = lane >> 4;
    P.p = src_col(kind, W, W2, c0 + c4) + (size_t)(k0 + kr) * srcN; P.gain = gain; P.wt = WT + (size_t)c0 * ldt + k0; P.srcN = srcN; P.ldt = ldt; P.k0 = k0;
}
constexpr int I_GU = 16 * 88, I_DN = 44 * 16, I_IN = 16 * 88, I_BP = 4 * 16, I_BA = 8 * 16, I_OUT = 16 * 16;
constexpr int I_LAYER = 2 * I_GU + 2 * I_DN + I_IN + 2 * I_BP + I_BA + I_OUT;
__device__ __forceinline__ void item_params(const Ctx& C, int it, int lane, ItemP& P) {
    const int l = it / I_LAYER; int r = it - l * I_LAYER;
    unsigned char* wl = C.ws + WS_W + (size_t)l * W_LAYER;
    if (r < I_GU) { item_set(P, 1, C.in[8] + (size_t)l * DM * DFF, C.in[9] + (size_t)l * DM * DFF, DFF, C.in[7] + l * DM, (bf16_t*)(wl + W_GU1), DM, r / 88, r % 88, lane); return; } r -= I_GU;
    if (r < I_GU) { item_set(P, 1, C.in[23] + (size_t)l * DM * DFF, C.in[24] + (size_t)l * DM * DFF, DFF, C.in[22] + l * DM, (bf16_t*)(wl + W_GU2), DM, r / 88, r % 88, lane); return; } r -= I_GU;
    if (r < I_DN) { item_set(P, 0, C.in[10] + (size_t)l * DFF * DM, nullptr, DM, nullptr, (bf16_t*)(wl + W_DN1), DFF, r / 16, r % 16, lane); return; } r -= I_DN;
    if (r < I_DN) { item_set(P, 0, C.in[25] + (size_t)l * DFF * DM, nullptr, DM, nullptr, (bf16_t*)(wl + W_DN2), DFF, r / 16, r % 16, lane); return; } r -= I_DN;
    if (r < I_IN) { item_set(P, 2, C.in[12] + (size_t)l * DM * NIN, nullptr, NIN, C.in[11] + l * DM, (bf16_t*)(wl + W_IN), DM, r / 88, r % 88, lane); return; } r -= I_IN;
    if (r < I_BP) { item_set(P, 0, C.in[15] + (size_t)l * 256 * DM, nullptr, DM, nullptr, (bf16_t*)(wl + W_BR), DM, r / 16, r % 16, lane); return; } r -= I_BP;
    if (r < I_BP) { item_set(P, 0, C.in[17] + (size_t)l * 256 * DM, nullptr, DM, nullptr, (bf16_t*)(wl + W_BR) + 256, DM, r / 16, r % 16, lane); return; } r -= I_BP;
    if (r < I_BA) { item_set(P, 0, C.in[20] + (size_t)l * 512 * DM, nullptr, DM, nullptr, (bf16_t*)(wl + W_BR) + 512, DM, r / 16, r % 16, lane); return; } r -= I_BA;
    item_set(P, 0, C.in[21] + (size_t)l * DM * DM, nullptr, DM, nullptr, (bf16_t*)(wl + W_OUT), DM, r / 16, r % 16, lane);
}
__device__ __forceinline__ void convert_items(const Ctx& C, unsigned char* shm, int it_lo, int it_hi, int gw0, int ngw) {
    const int tid = opaque_tid(), lane = tid & 63, wave = tid >> 6;
    float* scr = (float*)(shm + wave * 16640);
    const int c4 = (lane & 15) * 4, kr = lane >> 4, c8 = lane & 7;
    int it = it_lo + gw0;
    if (it >= it_hi) return;
    ItemP P; item_params(C, it, lane, P);
    f32x4 v[16];
#pragma unroll
    for (int i = 0; i < 16; ++i) v[i] = *(const f32x4*)(P.p + (size_t)(4 * i) * P.srcN);
    for (;;) {
#pragma unroll
        for (int i = 0; i < 16; ++i) {
            const int kk = 4 * i + kr; const float gs = P.gain ? P.gain[P.k0 + kk] : 1.f;
            float* d = scr + kk * 65 + c4;
            d[0] = v[i][0] * gs; d[1] = v[i][1] * gs; d[2] = v[i][2] * gs; d[3] = v[i][3] * gs;
        }
        const int nx = it + ngw; const bool has = nx < it_hi;
        ItemP Pn = P;
        if (has) {
            item_params(C, nx, lane, Pn);
#pragma unroll
            for (int i = 0; i < 16; ++i) v[i] = *(const f32x4*)(Pn.p + (size_t)(4 * i) * Pn.srcN);
        }
        asm volatile("s_waitcnt lgkmcnt(0)" ::: "memory");
#pragma unroll
        for (int j = 0; j < 8; ++j) { const int n = (lane >> 3) + 8 * j; const float* s = scr + (8 * c8) * 65 + n;
            u32x4 o; o.x = cvt_pk_bf16(s[0 * 65], s[1 * 65]); o.y = cvt_pk_bf16(s[2 * 65], s[3 * 65]); o.z = cvt_pk_bf16(s[4 * 65], s[5 * 65]); o.w = cvt_pk_bf16(s[6 * 65], s[7 * 65]);
            *(u32x4*)(P.wt + (size_t)n * P.ldt + 8 * c8) = o; }
        asm volatile("s_waitcnt lgkmcnt(0)" ::: "memory");
        if (!has) break;
        it = nx; P = Pn;
    }
}

__device__ __forceinline__ void prologue_phase(const Ctx& C, unsigned char* shm) {
    const int tid = opaque_tid(), lane = tid & 63, wave = tid >> 6;
    const int gw = blockIdx.x * 8 + wave, NGW = gridDim.x * 8;
    convert_items(C, shm, 0, (gridDim.x > 160) ? I_LAYER : 2 * I_LAYER, gw, NGW);
    for (int m = gw; m < MP; m += NGW) {
        f32x4 v[4];
        if (m < MR) {
            const float* src;
            if (m < NPR) { const int b = m / TP, t = m - b * TP; src = (t < 16) ? C.in[6] + (size_t)t * DM : C.in[0] + ((size_t)b * 4096 + (t - 16)) * DM; }
            else src = C.in[1] + (size_t)(m - NPR) * DM;
#pragma unroll
            for (int j = 0; j < 4; ++j) v[j] = *((const f32x4*)src + lane + 64 * j);
        } else {
#pragma unroll
            for (int j = 0; j < 4; ++j) v[j] = (f32x4){0.f, 0.f, 0.f, 0.f};
        }
        float s = 0.f;
#pragma unroll
        for (int j = 0; j < 4; ++j) { s += v[j][0] * v[j][0] + v[j][1] * v[j][1] + v[j][2] * v[j][2] + v[j][3] * v[j][3];
            *((u32x2*)(C.XB + (size_t)m * DM) + lane + 64 * j) = pk4(v[j]); }
        s = wave_sum(s);
        if (lane == 0) C.RSS[m] = s;
        if (lane >= 1 && lane < 7) C.RSS[(size_t)lane * MP + m] = 0.f;
    }
}

typedef float f32x2 __attribute__((ext_vector_type(2)));
template <bool MASK>
__device__ __forceinline__ void sb_math(const f32x16& st, int kb, int tq, int hi, float& carry, bf16x8& p0, bf16x8& p1) {
    f32x2 e2[8], x2[8];
#pragma unroll
    for (int p = 0; p < 8; ++p) {
        float e0 = __builtin_amdgcn_exp2f(st[2 * p]), e1 = __builtin_amdgcn_exp2f(st[2 * p + 1]);
        if (MASK) { const int key = kb + crow(2 * p, hi); e0 = (key >= 0 && key < tq) ? e0 : 0.f; e1 = (key + 1 >= 0 && key + 1 < tq) ? e1 : 0.f; }
        e2[p] = (f32x2){e0, e1};
        const f32x2 d = e2[p] + (f32x2){1.f, 1.f};
        x2[p] = (f32x2){__builtin_amdgcn_rcpf(d.x), __builtin_amdgcn_rcpf(d.y)};
    }
    float g0[4], g1[4];
#pragma unroll
    for (int c = 0; c < 4; ++c) {
        const float X3 = x2[2 * c + 1].y, X2 = x2[2 * c + 1].x * X3, X1 = x2[2 * c].y * X2, X0 = x2[2 * c].x * X1;
        x2[2 * c] = (f32x2){X0, X1}; x2[2 * c + 1] = (f32x2){X2, X3};
        auto rr = __builtin_amdgcn_permlane32_swap(__float_as_uint(X0), __float_as_uint(X0), false, false);
        g0[c] = __uint_as_float(rr[0]); g1[c] = __uint_as_float(rr[1]);
    }
    const float T7 = carry, T6 = T7 * g1[3], T5 = T6 * g0[3], T4 = T5 * g1[2], T3 = T4 * g0[2], T2 = T3 * g1[1], T1 = T2 * g0[1], T0 = T1 * g1[0];
    carry = T0 * g0[0];
    const float t0 = hi ? T1 : T0, t1 = hi ? T3 : T2, t2 = hi ? T5 : T4, t3 = hi ? T7 : T6;
    f32x2 a2[8];
    { const f32x2 tb = (f32x2){t0, t0}; a2[0] = e2[0] * (x2[0] * tb); a2[1] = e2[1] * (x2[1] * tb); }
    { const f32x2 tb = (f32x2){t1, t1}; a2[2] = e2[2] * (x2[2] * tb); a2[3] = e2[3] * (x2[3] * tb); }
    { const f32x2 tb = (f32x2){t2, t2}; a2[4] = e2[4] * (x2[4] * tb); a2[5] = e2[5] * (x2[5] * tb); }
    { const f32x2 tb = (f32x2){t3, t3}; a2[6] = e2[6] * (x2[6] * tb); a2[7] = e2[7] * (x2[7] * tb); }
    u32x4 q0, q1;
    q0.x = cvt_pk_bf16(a2[0].x, a2[0].y); q0.y = cvt_pk_bf16(a2[1].x, a2[1].y); q0.z = cvt_pk_bf16(a2[2].x, a2[2].y); q0.w = cvt_pk_bf16(a2[3].x, a2[3].y);
    q1.x = cvt_pk_bf16(a2[4].x, a2[4].y); q1.y = cvt_pk_bf16(a2[5].x, a2[5].y); q1.z = cvt_pk_bf16(a2[6].x, a2[6].y); q1.w = cvt_pk_bf16(a2[7].x, a2[7].y);
    p0 = __builtin_bit_cast(bf16x8, q0); p1 = __builtin_bit_cast(bf16x8, q1);
}

constexpr int AT_KROW = 144, AT_VROW = 136, AT_KBYTES = 64 * AT_KROW, AT_BUF = AT_KBYTES + 64 * AT_VROW;

__device__ __forceinline__ void attn_main_unit(const Ctx& C, int b, int h, int j, unsigned char* shm) {
    const int tid = opaque_tid(), lane = tid & 63, qi = lane & 31, hi = lane >> 5, w = __builtin_amdgcn_readfirstlane(tid >> 6);
    const int tq0 = 16 + 256 * j + 32 * w, tq = tq0 + qi;
    const size_t qrow = (size_t)b * TP + tq;
    bf16x8 qf[4];
#pragma unroll
    for (int s = 0; s < 4; ++s) qf[s] = *(const bf16x8*)(C.Q + qrow * 512 + 64 * h + 16 * s + 8 * hi);
    f32x16 o0, o1;
#pragma unroll
    for (int r = 0; r < 16; ++r) { o0[r] = 0.f; o1[r] = 0.f; }
    float carry = 1.f;
    const int itop = 4 * j + 4, wtop = 4 * j + (32 * w + 94) / 64;
    const int srow = tid >> 3, sch = tid & 7;
    const bf16_t* kg = C.KP + ((ptrdiff_t)b * TP - 48 + srow) * 512 + 64 * h + 8 * sch;
    const bf16_t* vg = C.VB + ((ptrdiff_t)b * TP - 48 + srow) * 512 + 64 * h + 8 * sch;
    u32x4 kreg = *(const u32x4*)(kg + (size_t)itop * 64 * 512), vreg = *(const u32x4*)(vg + (size_t)itop * 64 * 512);
    unsigned* flg = (unsigned*)(shm + 2 * AT_BUF);
    if (tid < 2) flg[tid] = 0u;
    bool wdone = false;
    for (int i = itop; i >= 0; --i) {
        unsigned char* kb_ = shm + (i & 1) * AT_BUF; unsigned char* vb_ = kb_ + AT_KBYTES;
        *(u32x4*)(kb_ + srow * AT_KROW + sch * 16) = kreg;
        {
            bf16_t* vw = (bf16_t*)(vb_ + (8 * sch) * AT_VROW + srow * 2);
            vw[0 * (AT_VROW / 2)] = (bf16_t)(vreg.x & 0xffffu); vw[1 * (AT_VROW / 2)] = (bf16_t)(vreg.x >> 16);
            vw[2 * (AT_VROW / 2)] = (bf16_t)(vreg.y & 0xffffu); vw[3 * (AT_VROW / 2)] = (bf16_t)(vreg.y >> 16);
            vw[4 * (AT_VROW / 2)] = (bf16_t)(vreg.z & 0xffffu); vw[5 * (AT_VROW / 2)] = (bf16_t)(vreg.z >> 16);
            vw[6 * (AT_VROW / 2)] = (bf16_t)(vreg.w & 0xffffu); vw[7 * (AT_VROW / 2)] = (bf16_t)(vreg.w >> 16);
        }
        if (i > 0) { kreg = *(const u32x4*)(kg + (size_t)(i - 1) * 64 * 512); vreg = *(const u32x4*)(vg + (size_t)(i - 1) * 64 * 512); }
        asm volatile("s_waitcnt lgkmcnt(0)" ::: "memory"); __builtin_amdgcn_s_barrier(); asm volatile("" ::: "memory");
        if (i < itop) { const unsigned fw = (unsigned)__builtin_amdgcn_readfirstlane((int)((volatile unsigned*)flg)[(i + 1) & 1]); if (fw == 0xFFu) break; }
        if (i <= wtop && !wdone) {
#pragma unroll
            for (int sub = 1; sub >= 0; --sub) {
                const int kb = 64 * i - 48 + 32 * sub;
                if (kb > tq0 + 30 || kb + 31 < 0) continue;
                const bool need_mask = (kb + 31 >= tq0) || (kb < 0);
                f32x16 st;
#pragma unroll
                for (int r = 0; r < 16; ++r) st[r] = 0.f;
#pragma unroll
                for (int s = 0; s < 4; ++s) { const bf16x8 kf = *(const bf16x8*)(kb_ + (32 * sub + qi) * AT_KROW + 32 * s + 16 * hi); st = __builtin_amdgcn_mfma_f32_32x32x16_bf16(kf, qf[s], st, 0, 0, 0); }
                bf16x8 p0, p1;
                if (need_mask) sb_math<true>(st, kb, tq, hi, carry, p0, p1); else sb_math<false>(st, kb, tq, hi, carry, p0, p1);
#pragma unroll
                for (int s = 0; s < 2; ++s) {
                    const unsigned char* vp0 = vb_ + qi * AT_VROW + (32 * sub + 16 * s + 4 * hi) * 2;
                    const unsigned char* vp1 = vp0 + 32 * AT_VROW;
                    const s16x4 a0 = *(const s16x4*)vp0, a1 = *(const s16x4*)(vp0 + 16), b0 = *(const s16x4*)vp1, b1 = *(const s16x4*)(vp1 + 16);
                    const bf16x8 v0 = (bf16x8){a0[0], a0[1], a0[2], a0[3], a1[0], a1[1], a1[2], a1[3]}, v1 = (bf16x8){b0[0], b0[1], b0[2], b0[3], b1[0], b1[1], b1[2], b1[3]};
                    o0 = __builtin_amdgcn_mfma_f32_32x32x16_bf16(v0, s ? p1 : p0, o0, 0, 0, 0);
                    o1 = __builtin_amdgcn_mfma_f32_32x32x16_bf16(v1, s ? p1 : p0, o1, 0, 0, 0);
                }
            }
            wdone = (__builtin_amdgcn_ballot_w64(carry != 0.f) == 0ull);
        }
        if (wdone && lane == 0) __hip_atomic_fetch_or(flg + (i & 1), 1u << w, __ATOMIC_RELAXED, __HIP_MEMORY_SCOPE_WORKGROUP);
    }
    bf16_t* op = C.PRE + qrow * DM + 512 + 64 * h + 4 * hi;
#pragma unroll
    for (int c = 0; c < 4; ++c) {
        *(u32x2*)(op + 8 * c) = (u32x2){cvt_pk_bf16(o0[4 * c], o0[4 * c + 1]), cvt_pk_bf16(o0[4 * c + 2], o0[4 * c + 3])};
        *(u32x2*)(op + 32 + 8 * c) = (u32x2){cvt_pk_bf16(o1[4 * c], o1[4 * c + 1]), cvt_pk_bf16(o1[4 * c + 2], o1[4 * c + 3])};
    }
    __syncthreads();
}

__device__ __forceinline__ void attn_skinny_unit(const Ctx& C, const float* k0, const float* v0, const float* k1, const float* v1, int S0, int S, int tq_base, size_t qrow_base, int h, unsigned char* shm) {
    const int tid = opaque_tid(), lane = tid & 63, qi = lane & 31, hi = lane >> 5, w = __builtin_amdgcn_readfirstlane(tid >> 6), q16 = qi & 15;
    const int tq = tq_base + q16;
    bf16x8 qf[4];
#pragma unroll
    for (int s = 0; s < 4; ++s) qf[s] = *(const bf16x8*)(C.Q + (qrow_base + q16) * 512 + 64 * h + 16 * s + 8 * hi);
    f32x16 o0, o1;
#pragma unroll
    for (int r = 0; r < 16; ++r) { o0[r] = 0.f; o1[r] = 0.f; }
    float carry = 1.f;
    const int nsb = (S + 31) >> 5, per = (nsb + 7) >> 3, sb_lo = w * per, sb_hi = min(nsb, sb_lo + per);
    for (int sb = sb_hi - 1; sb >= sb_lo; --sb) {
        const int kb = 32 * sb;
        const int key = min(kb + qi, S - 1);
        const float* kr = (key < S0 ? k0 + (size_t)key * 512 : k1 + (size_t)(key - S0) * 512) + 64 * h + 8 * hi;
        f32x16 st;
#pragma unroll
        for (int r = 0; r < 16; ++r) st[r] = 0.f;
#pragma unroll
        for (int s = 0; s < 4; ++s) {
            const f32x4 a = *(const f32x4*)(kr + 16 * s), bq = *(const f32x4*)(kr + 16 * s + 4);
            u32x4 pk; pk.x = cvt_pk_bf16(a[0], a[1]); pk.y = cvt_pk_bf16(a[2], a[3]); pk.z = cvt_pk_bf16(bq[0], bq[1]); pk.w = cvt_pk_bf16(bq[2], bq[3]);
            st = __builtin_amdgcn_mfma_f32_32x32x16_bf16(__builtin_bit_cast(bf16x8, pk), qf[s], st, 0, 0, 0);
        }
        bf16x8 p0, p1;
        sb_math<true>(st, kb, tq, hi, carry, p0, p1);
#pragma unroll
        for (int s = 0; s < 2; ++s) {
            float va[8], vb[8];
#pragma unroll
            for (int jj = 0; jj < 8; ++jj) {
                const int kk = min(kb + 16 * s + 4 * hi + (jj < 4 ? jj : jj + 4), S - 1);
                const float* vr = (kk < S0 ? v0 + (size_t)kk * 512 : v1 + (size_t)(kk - S0) * 512) + 64 * h + qi;
                va[jj] = vr[0]; vb[jj] = vr[32];
            }
            u32x4 pa, pb;
            pa.x = cvt_pk_bf16(va[0], va[1]); pa.y = cvt_pk_bf16(va[2], va[3]); pa.z = cvt_pk_bf16(va[4], va[5]); pa.w = cvt_pk_bf16(va[6], va[7]);
            pb.x = cvt_pk_bf16(vb[0], vb[1]); pb.y = cvt_pk_bf16(vb[2], vb[3]); pb.z = cvt_pk_bf16(vb[4], vb[5]); pb.w = cvt_pk_bf16(vb[6], vb[7]);
            o0 = __builtin_amdgcn_mfma_f32_32x32x16_bf16(__builtin_bit_cast(bf16x8, pa), s ? p1 : p0, o0, 0, 0, 0);
            o1 = __builtin_amdgcn_mfma_f32_32x32x16_bf16(__builtin_bit_cast(bf16x8, pb), s ? p1 : p0, o1, 0, 0, 0);
        }
    }
    float* OW = (float*)shm;
    float* RW = OW + 8 * 16 * 64;
    if (qi < 16) {
#pragma unroll
        for (int r = 0; r < 16; ++r) { OW[(w * 16 + qi) * 64 + crow(r, hi)] = o0[r]; OW[(w * 16 + qi) * 64 + 32 + crow(r, hi)] = o1[r]; }
        if (hi == 0) RW[w * 16 + qi] = carry;
    }
    __syncthreads();
    {
        const int q = tid >> 5, d = (tid & 31) * 2;
        float c = 1.f, a0 = 0.f, a1 = 0.f;
#pragma unroll
        for (int ww = 7; ww >= 0; --ww) { a0 += OW[(ww * 16 + q) * 64 + d] * c; a1 += OW[(ww * 16 + q) * 64 + d + 1] * c; c *= RW[ww * 16 + q]; }
        *(unsigned*)(C.PRE + (qrow_base + q) * DM + 512 + 64 * h + d) = cvt_pk_bf16(a0, a1);
    }
    __syncthreads();
}

template <int MODE>
__device__ __forceinline__ void poolconv_wave(const Ctx& C, int l, int ch, int g, int lane, float* PL) {
    constexpr bool samp = (MODE == 2);
    const int b = samp ? ch - 1028 : ch / 257, t0 = samp ? 0 : 16 * (ch % 257);
    const size_t rowbase = samp ? (size_t)NPR + 16 * b : (size_t)b * TP + t0;
    const int pos0 = samp ? 1024 : 0, c = 64 * g + lane, wnd = 2 << g;
    const float* spool = C.in[4] + ((size_t)l * 32 + b) * 15 * 256;
    const float* sconv = C.in[5] + ((size_t)l * 32 + b) * 2 * 256;
    float s[31], a[16];
#pragma unroll
    for (int r = 0; r < 31; ++r) {
        float v;
        if (MODE == 0) v = bf2f(C.PAB[(rowbase + (r - 15)) * DM + c]);
        else if (r >= 15) v = bf2f(C.PAB[(rowbase + (r - 15)) * DM + c]);
        else if (MODE == 2) v = spool[r * 256 + c];
        else v = 0.f;
        s[r] = v;
    }
#pragma unroll
    for (int i = 0; i < 16; ++i) a[i] = s[15 + i];
#pragma unroll
    for (int i = 30; i >= 1; --i) s[i] += s[i - 1];
    if (g >= 1) {
#pragma unroll
        for (int i = 30; i >= 3; --i) s[i] += s[i - 2];
    }
    if (g >= 2) {
#pragma unroll
        for (int i = 30; i >= 7; --i) s[i] += s[i - 4];
    }
    if (g >= 3) {
#pragma unroll
        for (int i = 30; i >= 15; --i) s[i] += s[i - 8];
    }
    float p[16], acc[16];
#pragma unroll
    for (int i = 0; i < 16; ++i) { const int pos = pos0 + t0 + i; p[i] = s[15 + i] / (float)min(pos + 1, wnd) - a[i]; acc[i] = 0.f; }
    const float* wp = C.in[13] + ((size_t)l * 4 + g) * 4096 + lane;
#pragma unroll
    for (int i = 0; i < 16; ++i) PL[i * 64 + lane] = p[i];
    asm volatile("s_waitcnt lgkmcnt(0)" ::: "memory");
#pragma unroll 2
    for (int k4 = 0; k4 < 16; ++k4) {
        const float w0 = wp[(4 * k4 + 0) * 64], w1 = wp[(4 * k4 + 1) * 64], w2 = wp[(4 * k4 + 2) * 64], w3 = wp[(4 * k4 + 3) * 64];
#pragma unroll
        for (int i = 0; i < 16; ++i) { const f32x4 pv = *(const f32x4*)(PL + i * 64 + 4 * k4); acc[i] += pv[0] * w0 + pv[1] * w1 + pv[2] * w2 + pv[3] * w3; }
    }
    asm volatile("s_waitcnt lgkmcnt(0)" ::: "memory");
    const float sc = C.in[14][l * 256 + c];
    const bool st_out = samp || t0 == 4096;
    float* pout = C.out + (samp ? OFF_PS + ((size_t)l * 32 + b) * 15 * 256 : OFF_PP + ((size_t)l * 4 + b) * 15 * 256) + c;
#pragma unroll
    for (int i = 0; i < 16; ++i) {
        C.PRE[(rowbase + i) * DM + c] = (bf16_t)(cvt_pk_bf16(acc[i] * sc, 0.f) & 0xffffu);
        if (st_out && i >= 1) pout[(i - 1) * 256] = a[i];
    }
    const float cw0 = C.in[16][(l * 3 + 0) * 256 + c], cw1 = C.in[16][(l * 3 + 1) * 256 + c], cw2 = C.in[16][(l * 3 + 2) * 256 + c];
    float e[18], gb[16];
#pragma unroll
    for (int i = 0; i < 18; ++i) {
        float v;
        if (MODE == 0 || i >= 2) { const bf16_t* r = C.PAB + (rowbase + (i - 2)) * DM; v = bf2f(r[768 + c]) * bf2f(r[256 + c]); }
        else if (MODE == 2) v = sconv[i * 256 + c];
        else v = 0.f;
        e[i] = v;
    }
#pragma unroll
    for (int i = 0; i < 16; ++i) gb[i] = bf2f(C.PAB[(rowbase + i) * DM + 512 + c]);
    float* cout = C.out + (samp ? OFF_CS + ((size_t)l * 32 + b) * 2 * 256 : OFF_CP + ((size_t)l * 4 + b) * 2 * 256) + c;
#pragma unroll
    for (int i = 0; i < 16; ++i) {
        const float y = gb[i] * (cw0 * e[i] + cw1 * e[i + 1] + cw2 * e[i + 2]);
        C.PRE[(rowbase + i) * DM + 256 + c] = (bf16_t)(cvt_pk_bf16(y, 0.f) & 0xffffu);
        if (st_out && i >= 14) cout[(i - 14) * 256] = e[i + 2];
    }
}

__device__ __forceinline__ void mixers_phase(const Ctx& C, int l, unsigned char* shm, int sub) {
    const int G = gridDim.x;
    if (sub & 1) for (int u = blockIdx.x; u < 256; u += G) {
        const int bh = (u & 7) * 4 + (u >> 6), jp = (u >> 3) & 7;
#ifndef NO_MAIN
        attn_main_unit(C, bh >> 3, bh & 7, 15 - jp, shm);
        attn_main_unit(C, bh >> 3, bh & 7, jp, shm);
#endif
    }
#ifndef NO_SKINNY
    if (sub & 2) for (int u = blockIdx.x; u < 288; u += G) {
        if (u < 256) {
            const int b = u >> 3, h = u & 7;
            attn_skinny_unit(C, C.in[2] + ((size_t)l * 32 + b) * 1024 * 512, C.in[3] + ((size_t)l * 32 + b) * 1024 * 512,
                             C.out + OFF_KS + ((size_t)l * NSR + 16 * b) * 512, C.out + OFF_VS + ((size_t)l * NSR + 16 * b) * 512, 1024, 1040, 1024, (size_t)NPR + 16 * b, h, shm);
        } else {
            const int b = (u - 256) >> 3, h = u & 7;
            const float* kp = C.out + OFF_KP + ((size_t)l * NPR + (size_t)b * TP) * 512; const float* vp = C.out + OFF_VP + ((size_t)l * NPR + (size_t)b * TP) * 512;
            attn_skinny_unit(C, kp, vp, kp, vp, 0, 16, 0, (size_t)b * TP, h, shm);
        }
    }
#endif
    if (sub & 4) {
        const int tid = opaque_tid(), lane = tid & 63, gw = blockIdx.x * 8 + __builtin_amdgcn_readfirstlane(tid >> 6), NGW = G * 8;
#ifndef NO_POOL
        for (int u = gw; u < 4240; u += NGW) {
            const int ch = u >> 2, g = u & 3; float* PL = (float*)shm + (tid >> 6) * 1024;
            if (ch >= 1028) poolconv_wave<2>(C, l, ch, g, lane, PL);
            else if (ch % 257 == 0) poolconv_wave<1>(C, l, ch, g, lane, PL);
            else poolconv_wave<0>(C, l, ch, g, lane, PL);
        }
#endif
    }
}

#define XB_TMO      128
#define XB_XCNT(j)  (256  + 64 * (j))
#define XB_XSUB(j)  (1280 + 64 * (j))
#define XB_XGEN(j)  (2304 + 64 * (j))
#define XB_TOP      3328
#define XB_TOPGEN   3392
#define XCD_BAR_WORDS 3456
#define XB_SPIN_CAP (1u << 18)
__device__ __forceinline__ unsigned xb_ld(unsigned* p)              { return __hip_atomic_load(p, __ATOMIC_RELAXED, __HIP_MEMORY_SCOPE_AGENT); }
__device__ __forceinline__ unsigned xb_add(unsigned* p, unsigned v) { return __hip_atomic_fetch_add(p, v, __ATOMIC_RELAXED, __HIP_MEMORY_SCOPE_AGENT); }
__device__ __forceinline__ unsigned xb_xcc_id() { return (unsigned)__builtin_amdgcn_s_getreg((3 << 11) | 20) & 0xFu; }
#define XB_SPIN(cond, bar) do { unsigned _sp = 0; while (cond) { __builtin_amdgcn_s_sleep(1); \
    if ((++_sp & 255u) == 0u) { if (xb_ld(&(bar)[XB_TMO])) break; if (_sp > XB_SPIN_CAP) { atomicAdd(&(bar)[XB_TMO], 1u); break; } } } } while (0)
struct XcdBarrier { unsigned* bar; unsigned x; volatile LAS unsigned* st; };
__device__ __forceinline__ XcdBarrier xcd_barrier_post(unsigned* bar, volatile LAS unsigned* st) {
    XcdBarrier b; b.bar = bar; b.x = xb_xcc_id(); b.st = st;
    if (threadIdx.x == 0) (void)xb_add(&bar[XB_XCNT(b.x)], 1u);
    return b;
}
__device__ __forceinline__ void xcd_barrier_complete(unsigned* bar, unsigned x, unsigned& nloc, unsigned& nx) {
    const unsigned G = gridDim.x * gridDim.y * gridDim.z;
    unsigned sum, cnt, mine, sp = 0u;
    for (;;) {
        sum = 0u; cnt = 0u; mine = 0u;
#pragma unroll
        for (unsigned j = 0; j < 16; ++j) { const unsigned c = xb_ld(&bar[XB_XCNT(j)]); sum += c; cnt += (c > 0u) ? 1u : 0u; mine = (j == x) ? c : mine; }
        if (sum == G) break;
        __builtin_amdgcn_s_sleep(1);
        if ((++sp & 255u) == 0u) { if (xb_ld(&bar[XB_TMO])) break; if (sp > XB_SPIN_CAP) { atomicAdd(&bar[XB_TMO], 1u); break; } }
    }
    nloc = mine > 0u ? mine : 1u; nx = cnt > 0u ? cnt : 1u;
}
__device__ __forceinline__ void xcd_barrier(const XcdBarrier& b) {
    asm volatile("s_waitcnt vmcnt(0)" ::: "memory");
    __syncthreads();
    if (threadIdx.x == 0) {
        unsigned* bar = b.bar;
        __builtin_amdgcn_s_waitcnt(0);
        unsigned nloc = b.st[0], nx = b.st[1];
        if (nloc == 0u) { xcd_barrier_complete(bar, b.x, nloc, nx); b.st[0] = nloc; b.st[1] = nx; }
        const unsigned old = xb_add(&bar[XB_XSUB(b.x)], 1u);
        const unsigned gen = old / nloc;
        if (old + 1u == (gen + 1u) * nloc) {
            __builtin_amdgcn_fence(__ATOMIC_RELEASE, "agent");
            asm volatile("s_waitcnt vmcnt(0)" ::: "memory");
            const unsigned og = xb_add(&bar[XB_TOP], 1u);
            const unsigned tg = og / nx;
            if (og + 1u == (tg + 1u) * nx) xb_add(&bar[XB_TOPGEN], 1u);
            else XB_SPIN(xb_ld(&bar[XB_TOPGEN]) == tg, bar);
            __builtin_amdgcn_fence(__ATOMIC_ACQUIRE, "agent");
            xb_add(&bar[XB_XGEN(b.x)], 1u);
            asm volatile("s_waitcnt vmcnt(0)" ::: "memory");
        } else {
            XB_SPIN(xb_ld(&bar[XB_XGEN(b.x)]) == gen, bar);
            __builtin_amdgcn_fence(__ATOMIC_ACQUIRE, "agent");
            asm volatile("s_waitcnt vmcnt(0)" ::: "memory");
        }
    }
    __syncthreads();
}

__global__ void __launch_bounds__(512, 2) mk_fwd(Args args) {
    extern __shared__ __attribute__((aligned(16))) unsigned char shm[];
    Ctx C;
    C.in = args.in; C.out = args.out; C.ws = args.ws;
    C.RSS = (float*)(args.ws + WS_RSS); C.XB = (bf16_t*)(args.ws + WS_XB); C.HF = (float*)(args.ws + WS_HF); C.ACT = (bf16_t*)(args.ws + WS_ACT); C.G = (bf16_t*)(args.ws + WS_G);
    C.PA = (float*)(args.ws + WS_PA); C.PAB = (bf16_t*)(args.ws + WS_PA); C.MIXF = (float*)(args.ws + WS_MIXF); C.MIXB = (bf16_t*)(args.ws + WS_MIXB); C.Q = (bf16_t*)(args.ws + WS_Q); C.KP = (bf16_t*)(args.ws + WS_KP) + 48 * 512; C.VT = (bf16_t*)(args.ws + WS_VT); C.VB = (bf16_t*)(args.ws + WS_VT) + 48 * 512; C.PRE = (bf16_t*)(args.ws + WS_PRE);
    volatile LAS unsigned* bst = (volatile LAS unsigned*)((LAS unsigned char*)shm + LDS_CTL);
    if (threadIdx.x < 4) bst[threadIdx.x] = 0u;
    __syncthreads();
    XcdBarrier bar; bar.bar = (unsigned*)(args.ws + WS_BAR); bar.x = 0; bar.st = bst;
    if (args.ph_hi - args.ph_lo > 1) bar = xcd_barrier_post((unsigned*)(args.ws + WS_BAR), bst);
    for (int ph = args.ph_lo; ph < args.ph_hi; ++ph) {
      for (int rep = 0; rep < ((ph == REP_PH) ? 2 : 1); ++rep) {
#ifndef NO_PRO
        if (ph == 0) prologue_phase(C, shm);
#else
        if (ph == 0) {}
#endif
        else {
            const int l = __builtin_amdgcn_readfirstlane((ph - 1) >> 3), s = __builtin_amdgcn_readfirstlane((ph - 1) & 7);
#ifndef NO_MIX
            if (s == 3) mixers_phase(C, l, shm, rep ? REP_SUB : 7);
#else
            if (s == 3) {}
#endif
            else {
                unsigned char* wl = args.ws + WS_W + (size_t)l * W_LAYER;
                pg8::Gemm g; pg8::Sched S; pg8::EpiDesc E;
                S.nM = MP / 256; S.G = gridDim.x; S.c = blockIdx.x; S.segs = 1;
                E.l = l; E.final_ = 0; E.alpha = 1.f; E.rss_in = C.RSS; E.rss_out = C.RSS;
                if (s == 0 || s == 6) { g.A = C.XB; g.lda = DM; g.Bt = (const bf16_t*)(wl + (s == 0 ? W_GU1 : W_GU2)); g.ldb = DM; S.nN = NIN / 256; S.nt_full = DM / 64; E.kind = pg8::EK_SWIGLU; E.rss_in = C.RSS + (size_t)(3 * l + (s == 0 ? 0 : 2)) * MP; }
                else if (s == 1 || s == 7) { g.A = C.ACT; g.lda = DFF; g.Bt = (const bf16_t*)(wl + (s == 1 ? W_DN1 : W_DN2)); g.ldb = DFF; S.nN = 4; S.nt_full = DFF / 64; E.kind = pg8::EK_RESID; E.alpha = 0.5f; E.rss_out = C.RSS + (size_t)(3 * l + (s == 1 ? 1 : 3)) * MP; E.final_ = (s == 7 && l == 1); }
                else if (s == 2) { g.A = C.XB; g.lda = DM; g.Bt = (const bf16_t*)(wl + W_IN); g.ldb = DM; S.nN = NIN / 256; S.nt_full = DM / 64; E.kind = pg8::EK_PROJ; E.rss_in = C.RSS + (size_t)(3 * l + 1) * MP; }
                else if (s == 4) { g.A = C.PRE; g.lda = DM; g.Bt = (const bf16_t*)(wl + W_BR); g.ldb = DM; S.nN = 4; S.nt_full = 0; S.segs = 3; E.kind = pg8::EK_BRANCH; }
                else { g.A = C.MIXB; g.lda = DM; g.Bt = (const bf16_t*)(wl + W_OUT); g.ldb = DM; S.nN = 4; S.nt_full = DM / 64; E.kind = pg8::EK_RESID; E.alpha = 1.f; E.rss_out = C.RSS + (size_t)(3 * l + 2) * MP; }
                if (S.nN == 4) S.nM = 64;
                S.nwg = S.nM * S.nN;
#ifndef NO_GEMM
                if (PERM_MASK == 0) pg8::gemm_phase<false>((LAS unsigned char*)shm, g, S, E, C);
                else if (PERM_MASK == 15) pg8::gemm_phase<true>((LAS unsigned char*)shm, g, S, E, C);
                else if ((PERM_MASK >> E.kind) & 1) pg8::gemm_phase<true>((LAS unsigned char*)shm, g, S, E, C);
                else pg8::gemm_phase<false>((LAS unsigned char*)shm, g, S, E, C);
                if (S.nN == 4) for (int su = blockIdx.x; su < 144; su += gridDim.x) pg8::small_unit(g, E, C, su, shm);
                if (S.nN == 4 && l == 0 && gridDim.x > 160 && blockIdx.x >= 144) {
                    const int part = (s == 1) ? 0 : (s == 4) ? 1 : (s == 5) ? 2 : 3;
                    const int lo = I_LAYER + (I_LAYER * part) / 4, hi = I_LAYER + (I_LAYER * (part + 1)) / 4;
                    convert_items(C, shm, lo, hi, (blockIdx.x - 144) * 8 + (threadIdx.x >> 6), (gridDim.x - 144) * 8);
                }
#endif
            }
        }
      }
        if (ph + 1 < args.ph_hi) { if (args.ph_hi > 1000) cg::this_grid().sync(); else xcd_barrier(bar); }
    }
}

extern "C" void kernel_launch(void* const* d_in, const int* in_sizes, int n_in, void* d_out, int out_size, void* d_ws, size_t ws_size, hipStream_t stream) {
    static int grid = 0;
    if (grid == 0) {
        if (n_in != 26 || (size_t)out_size != OUT_TOTAL || ws_size < WS_END) { fprintf(stderr, "kernel_launch: unexpected shapes: n_in %d out %d ws %zu (need %zu)\n", n_in, out_size, ws_size, (size_t)WS_END); grid = -1; return; }
        int dev = 0, cus = 0, per_cu = 0;
        hipGetDevice(&dev); hipDeviceGetAttribute(&cus, hipDeviceAttributeMultiprocessorCount, dev);
        if (hipFuncSetAttribute((const void*)mk_fwd, hipFuncAttributeMaxDynamicSharedMemorySize, LDS_BYTES) != hipSuccess) { fprintf(stderr, "kernel_launch: hipFuncSetAttribute failed\n"); grid = -1; return; }
        if (hipOccupancyMaxActiveBlocksPerMultiprocessor(&per_cu, (const void*)mk_fwd, 512, LDS_BYTES) != hipSuccess || per_cu < 1) { fprintf(stderr, "kernel_launch: occupancy query says %d\n", per_cu); per_cu = 1; }
        (void)hipGetLastError();
        grid = cus * per_cu;
    }
    if (grid < 0) return;
    Args a{};
    for (int i = 0; i < 26; ++i) a.in[i] = (const float*)d_in[i];
    a.out = (float*)d_out; a.ws = (unsigned char*)d_ws;
#if MK_ONE_LAUNCH
    if (hipMemsetAsync((unsigned char*)d_ws + WS_BAR, 0, XCD_BAR_WORDS * 4, stream) != hipSuccess) { fprintf(stderr, "memset failed\n"); return; }
    a.ph_lo = 0; a.ph_hi = 17;
    void* kargs[] = {&a};
    hipError_t e = hipLaunchCooperativeKernel((const void*)mk_fwd, dim3(grid), dim3(512), kargs, LDS_BYTES, stream);
    if (e != hipSuccess) fprintf(stderr, "cooperative launch failed: %s (grid %d)\n", hipGetErrorString(e), grid);
#else
    for (int ph = 0; ph < 17; ++ph) { a.ph_lo = ph; a.ph_hi = ph + 1; hipLaunchKernelGGL(mk_fwd, dim3(grid), dim3(512), LDS_BYTES, stream, a); }
#endif
}
```

```cpp
#include <hip/hip_runtime.h>
#include <hip/hip_cooperative_groups.h>
#include <cstdio>
#include <cstdint>
namespace cg = cooperative_groups;

#ifndef REP_PH
#define REP_PH -1
#endif
#ifndef REP_SUB
#define REP_SUB 7
#endif
#ifndef PERM_MASK
#define PERM_MASK 8
#endif
#ifndef MK_ONE_LAUNCH
#define MK_ONE_LAUNCH 1
#endif

#define LAS __attribute__((address_space(3)))
typedef unsigned short bf16_t;
typedef short bf16x8 __attribute__((ext_vector_type(8)));
typedef short s16x4 __attribute__((ext_vector_type(4)));
typedef float f32x4 __attribute__((ext_vector_type(4)));
typedef float f32x16 __attribute__((ext_vector_type(16)));
typedef unsigned u32x4 __attribute__((ext_vector_type(4)));
typedef unsigned u32x2 __attribute__((ext_vector_type(2)));

constexpr int DM = 1024, TP = 4112, NPR = 4 * TP, NSR = 512, MR = NPR + NSR, MP = 17152, DFF = 2816, NIN = 5632;
constexpr int LDV = 4160;
constexpr float RMS_EPS = 1e-6f;
constexpr float QSCALE = 0.125f * 1.4426950408889634f;
constexpr size_t OFF_YP = 0;
constexpr size_t OFF_YS = OFF_YP + (size_t)4 * 4096 * 1024;
constexpr size_t OFF_KP = OFF_YS + (size_t)512 * 1024;
constexpr size_t OFF_VP = OFF_KP + (size_t)2 * NPR * 512;
constexpr size_t OFF_PP = OFF_VP + (size_t)2 * NPR * 512;
constexpr size_t OFF_CP = OFF_PP + (size_t)2 * 4 * 15 * 256;
constexpr size_t OFF_KS = OFF_CP + (size_t)2 * 4 * 2 * 256;
constexpr size_t OFF_VS = OFF_KS + (size_t)2 * 512 * 512;
constexpr size_t OFF_PS = OFF_VS + (size_t)2 * 512 * 512;
constexpr size_t OFF_CS = OFF_PS + (size_t)2 * 32 * 15 * 256;
constexpr size_t OUT_TOTAL = OFF_CS + (size_t)2 * 32 * 2 * 256;
constexpr size_t MiB = 1u << 20;
constexpr size_t WS_RSS = 0;
constexpr size_t WS_BAR = 768 * 1024;
constexpr size_t WS_W = 1 * MiB;
constexpr size_t W_GU1 = 0, W_DN1 = W_GU1 + (size_t)NIN * DM * 2, W_IN = W_DN1 + (size_t)DM * DFF * 2, W_BR = W_IN + (size_t)NIN * DM * 2,
                 W_OUT = W_BR + (size_t)DM * DM * 2, W_GU2 = W_OUT + (size_t)DM * DM * 2, W_DN2 = W_GU2 + (size_t)NIN * DM * 2, W_LAYER = W_DN2 + (size_t)DM * DFF * 2;
static_assert(W_LAYER == 48 * MiB, "weights per layer");
constexpr size_t WS_XB = 97 * MiB;
constexpr size_t WS_HF = 131 * MiB;
constexpr size_t WS_ACT = 198 * MiB;
constexpr size_t WS_G = 198 * MiB;
constexpr size_t WS_PA = 299 * MiB;
constexpr size_t WS_MIXF = 299 * MiB;
constexpr size_t WS_MIXB = 366 * MiB;
constexpr size_t WS_Q = 366 * MiB;
constexpr size_t WS_KP = 383 * MiB;
constexpr size_t WS_VT = 400 * MiB;
constexpr size_t WS_PRE = 421 * MiB;
constexpr size_t WS_END = 455 * MiB;
static_assert(WS_XB + (size_t)MP * DM * 2 <= WS_HF && WS_HF + (size_t)MP * DM * 4 <= WS_ACT && WS_G + (size_t)MP * 3072 * 2 <= WS_PA && WS_PA + (size_t)MP * DM * 4 <= WS_Q &&
              WS_Q + (size_t)MP * 512 * 2 <= WS_KP && WS_KP + (size_t)(48 + MP) * 1024 <= WS_VT && WS_VT + (size_t)40 * 64 * LDV * 2 <= WS_PRE && WS_PRE + (size_t)MP * DM * 2 <= WS_END, "ws map");
constexpr int LDS_CTL = 8 * 16640;
constexpr int LDS_BYTES = LDS_CTL + 64;

struct Args { const float* in[26]; float* out; unsigned char* ws; int ph_lo, ph_hi; };

struct Ctx {
    const float* const* in;
    float* out; unsigned char* ws;
    float* RSS; bf16_t* XB; float* HF; bf16_t* ACT; bf16_t* G; float* PA; float* MIXF; bf16_t* PAB; bf16_t* MIXB; bf16_t* Q; bf16_t* KP; bf16_t* VT; bf16_t* VB; bf16_t* PRE;
};

__device__ __forceinline__ unsigned cvt_pk_bf16(float lo, float hi) { unsigned r; asm volatile("v_cvt_pk_bf16_f32 %0, %1, %2" : "=v"(r) : "v"(lo), "v"(hi)); return r; }
__device__ __forceinline__ u32x2 pk4(f32x4 v) { u32x2 r; r.x = cvt_pk_bf16(v[0], v[1]); r.y = cvt_pk_bf16(v[2], v[3]); return r; }
__device__ __forceinline__ float bf2f(unsigned short b) { return __uint_as_float(((unsigned)b) << 16); }
__device__ __forceinline__ f32x4 unpk4(u32x2 p) { f32x4 r; r[0] = __uint_as_float(p.x << 16); r[1] = __uint_as_float(p.x & 0xffff0000u); r[2] = __uint_as_float(p.y << 16); r[3] = __uint_as_float(p.y & 0xffff0000u); return r; }
__device__ __forceinline__ int opaque_tid() { int t = threadIdx.x; asm volatile("" : "+v"(t)); return t; }
__device__ __forceinline__ int opaque_bid() { int t = blockIdx.x; asm volatile("" : "+s"(t)); return t; }
__device__ __forceinline__ int crow(int r, int hi) { return (r & 3) + 8 * (r >> 2) + 4 * hi; }

namespace pg8 {
constexpr int BM = 256, BK = 64, HALF = 128, HTB = HALF * BK * 2, STAGE_BYTES = 8 * HTB, NXCD = 8, WGM = 8;
__host__ __device__ __forceinline__ int lds_byte(int r, int c) { const int st = (r >> 4) * 2 + (c >> 5), rr = r & 15, cc = c & 31, ob = rr * 64 + cc * 2; return st * 1024 + (ob ^ (((ob >> 9) & 1) << 5)); }
__host__ __device__ __forceinline__ void stage_rc(int b, int& R, int& C) { const int st = b / 1024, sb = b % 1024, swz = sb ^ (((sb >> 9) & 1) << 5); R = (st >> 1) * 16 + swz / 64; C = (st & 1) * 32 + (swz % 64) / 2; }

struct Unit { int pm, pn, kofs, nt, seg; };
struct Gemm { const bf16_t* A; const bf16_t* Bt; int lda, ldb; };
struct Sched {
    int nM, nN, nwg, G, c, segs, nt_full;
    __device__ bool next(int i, Unit& u) const {
        const int ti = (segs == 3) ? i / 3 : i; const int sg = (segs == 3) ? i - 3 * ti : 3;
        const long L = (long)ti * G + c; if (L >= nwg) return false;
        int wgid = (int)L; { const int q = nwg / NXCD, r = nwg % NXCD, xcd = wgid % NXCD, off = wgid / NXCD; wgid = (xcd < r ? xcd * (q + 1) : r * (q + 1) + (xcd - r) * q) + off; }
        const int nig = WGM * nN, gid = wgid / nig, fm = gid * WGM, gsz = (nM - fm) < WGM ? (nM - fm) : WGM;
        u.pm = fm + ((wgid % nig) % gsz); u.pn = (wgid % nig) / gsz;
        u.seg = sg;
        if (segs == 3) { u.kofs = sg == 0 ? 0 : (sg == 1 ? 256 : 512); u.nt = sg == 2 ? 8 : 4; }
        else { u.kofs = 0; u.nt = nt_full; }
        return true;
    }
};
enum { EK_SWIGLU = 0, EK_RESID = 1, EK_PROJ = 2, EK_BRANCH = 3 };
struct EpiDesc { int kind, l, final_; float alpha; const float* rss_in; float* rss_out; };

__device__ __forceinline__ float sigmoidf_(float v) { return __builtin_amdgcn_rcpf(1.f + __builtin_amdgcn_exp2f(-1.4426950408889634f * v)); }

template <int K>
__device__ __forceinline__ void epilogue(const f32x4 (&acc)[2][2][4][2], const Unit& u, const EpiDesc& E, const Ctx& C, int wr, int wc, int fr, int fq) {
    const int row0 = u.pm * 256 + wr * 64 + fr;
    const int lc0 = 32 * wc + 4 * fq;
    if (K == EK_SWIGLU || K == EK_PROJ) {
        float rstd[2][4];
#pragma unroll
        for (int ai = 0; ai < 2; ++ai)
#pragma unroll
            for (int m = 0; m < 4; ++m) rstd[ai][m] = E.rss_in[row0 + 128 * ai + 16 * m];
#pragma unroll
        for (int ai = 0; ai < 2; ++ai)
#pragma unroll
            for (int m = 0; m < 4; ++m) rstd[ai][m] = __builtin_amdgcn_rsqf(rstd[ai][m] * (1.f / 1024.f) + RMS_EPS);
        if (K == EK_SWIGLU) {
#pragma unroll
            for (int ai = 0; ai < 2; ++ai)
#pragma unroll
                for (int m = 0; m < 4; ++m) {
                    const int row = row0 + 128 * ai + 16 * m;
#pragma unroll
                    for (int bj = 0; bj < 2; ++bj) {
                        const f32x4 g = acc[ai][bj][m][0] * rstd[ai][m], up = acc[ai][bj][m][1] * rstd[ai][m];
                        f32x4 a;
#pragma unroll
                        for (int i = 0; i < 4; ++i) a[i] = g[i] * sigmoidf_(g[i]) * up[i];
                        const int j = 16 * (8 * u.pn + 4 * bj + wc) + 4 * fq;
                        *(u32x2*)(C.ACT + (size_t)row * DFF + j) = pk4(a);
                    }
                }
        } else {
            const int pn = u.pn, l = E.l;
            if (pn < 4) {
#pragma unroll
                for (int ai = 0; ai < 2; ++ai)
#pragma unroll
                    for (int m = 0; m < 4; ++m) {
                        const int row = row0 + 128 * ai + 16 * m;
#pragma unroll
                        for (int bj = 0; bj < 2; ++bj)
#pragma unroll
                            for (int n = 0; n < 2; ++n) *(u32x2*)(C.PAB + (size_t)row * DM + 256 * pn + 128 * bj + 16 * n + lc0) = pk4(acc[ai][bj][m][n] * rstd[ai][m]);
                    }
            } else if (pn < 8) {
                const bool isk = pn >= 6; const int head = 4 * (pn & 1) + wc;
                const float* gn = C.in[isk ? 19 : 18] + (size_t)l * 512 + 64 * head + 4 * fq;
                f32x4 gv[2][2];
#pragma unroll
                for (int bj = 0; bj < 2; ++bj)
#pragma unroll
                    for (int n = 0; n < 2; ++n) gv[bj][n] = *(const f32x4*)(gn + 32 * bj + 16 * n) * (isk ? 1.f : QSCALE);
#pragma unroll
                for (int ai = 0; ai < 2; ++ai)
#pragma unroll
                    for (int m = 0; m < 4; ++m) {
                        const int row = row0 + 128 * ai + 16 * m;
                        f32x4 v[2][2]; float ss = 0.f;
#pragma unroll
                        for (int bj = 0; bj < 2; ++bj)
#pragma unroll
                            for (int n = 0; n < 2; ++n) { v[bj][n] = acc[ai][bj][m][n] * rstd[ai][m]; ss += v[bj][n][0] * v[bj][n][0] + v[bj][n][1] * v[bj][n][1] + v[bj][n][2] * v[bj][n][2] + v[bj][n][3] * v[bj][n][3]; }
                        ss += __shfl_xor(ss, 16); ss += __shfl_xor(ss, 32);
                        const float rinv = __builtin_amdgcn_rsqf(ss * (1.f / 64.f) + RMS_EPS);
                        float* kdst = (float*)(C.PRE + (size_t)row * DM);
                        if (row < NPR) kdst = C.out + OFF_KP + ((size_t)l * NPR + row) * 512; else if (row < MR) kdst = C.out + OFF_KS + ((size_t)l * NSR + (row - NPR)) * 512;
                        bf16_t* bdst = (isk ? C.KP : C.Q) + (size_t)row * 512 + 64 * head + 4 * fq;
#pragma unroll
                        for (int bj = 0; bj < 2; ++bj)
#pragma unroll
                            for (int n = 0; n < 2; ++n) {
                                const int d = 32 * bj + 16 * n;
                                const f32x4 o = v[bj][n] * rinv * gv[bj][n];
                                *(u32x2*)(bdst + d) = pk4(o);
                                if (isk) *(f32x4*)(kdst + 64 * head + 4 * fq + d) = o;
                            }
                    }
            } else if (pn < 10) {
#pragma unroll
                for (int ai = 0; ai < 2; ++ai)
#pragma unroll
                    for (int m = 0; m < 4; ++m) {
                        const int row = row0 + 128 * ai + 16 * m;
                        float* vdst = (float*)(C.PRE + (size_t)row * DM);
                        if (row < NPR) vdst = C.out + OFF_VP + ((size_t)l * NPR + row) * 512; else if (row < MR) vdst = C.out + OFF_VS + ((size_t)l * NSR + (row - NPR)) * 512;
#pragma unroll
                        for (int bj = 0; bj < 2; ++bj)
#pragma unroll
                            for (int n = 0; n < 2; ++n) {
                                const int c512 = 256 * (pn - 8) + 128 * bj + 16 * n + lc0;
                                const f32x4 o = acc[ai][bj][m][n] * rstd[ai][m];
                                *(f32x4*)(vdst + c512) = o;
                                *(u32x2*)(C.VB + (size_t)row * 512 + c512) = pk4(o);
                            }
                    }
            } else {
                const int br = (pn - 10) >> 2, cb = 256 * ((pn - 10) & 3);
#pragma unroll
                for (int ai = 0; ai < 2; ++ai)
#pragma unroll
                    for (int m = 0; m < 4; ++m) {
                        const int row = row0 + 128 * ai + 16 * m;
#pragma unroll
                        for (int bj = 0; bj < 2; ++bj)
#pragma unroll
                            for (int n = 0; n < 2; ++n) {
                                const f32x4 x = acc[ai][bj][m][n] * rstd[ai][m]; f32x4 sg;
#pragma unroll
                                for (int i = 0; i < 4; ++i) sg[i] = fmaxf(sigmoidf_(x[i]), 1e-30f);
                                *(u32x2*)(C.G + (size_t)row * 3072 + br * 1024 + cb + 128 * bj + 16 * n + lc0) = pk4(sg);
                            }
                    }
            }
        }
    } else if (K == EK_RESID) {
#pragma unroll
        for (int ai = 0; ai < 2; ++ai)
#pragma unroll
        for (int mh = 0; mh < 2; ++mh) {
            u32x2 h[2][2][2];
#pragma unroll
            for (int m2 = 0; m2 < 2; ++m2)
#pragma unroll
                for (int bj = 0; bj < 2; ++bj)
#pragma unroll
                    for (int n = 0; n < 2; ++n) h[m2][bj][n] = *(const u32x2*)(C.XB + (size_t)(row0 + 128 * ai + 16 * (2 * mh + m2)) * DM + 256 * u.pn + 128 * bj + 16 * n + lc0);
#pragma unroll
            for (int m2 = 0; m2 < 2; ++m2) {
                const int m = 2 * mh + m2;
                const int row = row0 + 128 * ai + 16 * m;
                float* dst = C.PA + (size_t)row * DM;
                if (E.final_) {
                    if (row < NPR) { const int b = row / TP, t = row - b * TP; if (t >= 16) dst = C.out + OFF_YP + ((size_t)b * 4096 + (t - 16)) * 1024; }
                    else if (row < MR) dst = C.out + OFF_YS + (size_t)(row - NPR) * 1024;
                }
                float ss = 0.f;
#pragma unroll
                for (int bj = 0; bj < 2; ++bj)
#pragma unroll
                    for (int n = 0; n < 2; ++n) {
                        const int col = 256 * u.pn + 128 * bj + 16 * n + lc0;
                        const f32x4 hv = unpk4(h[m2][bj][n]) + acc[ai][bj][m][n] * E.alpha;
                        if (E.final_) *(f32x4*)(dst + col) = hv;
                        else {
                            *(u32x2*)(C.XB + (size_t)row * DM + col) = pk4(hv);
                            ss += hv[0] * hv[0] + hv[1] * hv[1] + hv[2] * hv[2] + hv[3] * hv[3];
                        }
                    }
                if (!E.final_) {
                    ss += __shfl_xor(ss, 16); ss += __shfl_xor(ss, 32);
                    if (fq == 0) unsafeAtomicAdd(E.rss_out + row, ss);
                }
            }
        }
    } else {
        const int seg = u.seg;
#pragma unroll
        for (int ai = 0; ai < 2; ++ai)
#pragma unroll
        for (int mh = 0; mh < 2; ++mh) {
            u32x2 gq[2][2][2], mf[2][2][2];
#pragma unroll
            for (int m2 = 0; m2 < 2; ++m2)
#pragma unroll
                for (int bj = 0; bj < 2; ++bj)
#pragma unroll
                    for (int n = 0; n < 2; ++n) {
                        const int row = row0 + 128 * ai + 16 * (2 * mh + m2), col = 256 * u.pn + 128 * bj + 16 * n + lc0;
                        gq[m2][bj][n] = *(const u32x2*)(C.G + (size_t)row * 3072 + seg * 1024 + col);
                        if (seg > 0) mf[m2][bj][n] = *(const u32x2*)(C.MIXB + (size_t)row * DM + col); else mf[m2][bj][n] = (u32x2){0u, 0u};
                    }
#pragma unroll
            for (int m2 = 0; m2 < 2; ++m2)
#pragma unroll
                for (int bj = 0; bj < 2; ++bj)
#pragma unroll
                    for (int n = 0; n < 2; ++n) {
                        const int row = row0 + 128 * ai + 16 * (2 * mh + m2), col = 256 * u.pn + 128 * bj + 16 * n + lc0;
                        const f32x4 r = acc[ai][bj][2 * mh + m2][n] * unpk4(gq[m2][bj][n]) + unpk4(mf[m2][bj][n]);
                        *(u32x2*)(C.MIXB + (size_t)row * DM + col) = pk4(r);
                    }
        }
    }
}

__host__ __device__ __forceinline__ int perm32(int rho) { const int n = rho >> 4, i = rho & 15; return 8 * (i >> 2) + 4 * n + (i & 3); }
__device__ __forceinline__ u32x4 pk8(f32x4 a, f32x4 b) { const u32x2 p = pk4(a), q = pk4(b); return (u32x4){p.x, p.y, q.x, q.y}; }
template <int K>
__device__ __forceinline__ void epilogue_p(const f32x4 (&acc)[2][2][4][2], const Unit& u, const EpiDesc& E, const Ctx& C, int wr, int wc, int fr, int fq) {
    const int row0 = u.pm * 256 + wr * 64 + fr;
    const int lc8 = 32 * wc + 8 * fq;
    if (K == EK_SWIGLU || K == EK_PROJ) {
        float rstd[2][4];
#pragma unroll
        for (int ai = 0; ai < 2; ++ai)
#pragma unroll
            for (int m = 0; m < 4; ++m) rstd[ai][m] = E.rss_in[row0 + 128 * ai + 16 * m];
#pragma unroll
        for (int ai = 0; ai < 2; ++ai)
#pragma unroll
            for (int m = 0; m < 4; ++m) rstd[ai][m] = __builtin_amdgcn_rsqf(rstd[ai][m] * (1.f / 1024.f) + RMS_EPS);
        if (K == EK_SWIGLU) {
#pragma unroll
            for (int ai = 0; ai < 2; ++ai)
#pragma unroll
                for (int m = 0; m < 4; ++m) {
                    const int row = row0 + 128 * ai + 16 * m;
                    f32x4 a[2];
#pragma unroll
                    for (int n = 0; n < 2; ++n) {
                        const f32x4 g = acc[ai][0][m][n] * rstd[ai][m], up = acc[ai][1][m][n] * rstd[ai][m];
#pragma unroll
                        for (int i = 0; i < 4; ++i) a[n][i] = g[i] * sigmoidf_(g[i]) * up[i];
                    }
                    *(u32x4*)(C.ACT + (size_t)row * DFF + 128 * u.pn + lc8) = pk8(a[0], a[1]);
                }
        } else {
            const int pn = u.pn, l = E.l;
            if (pn < 4) {
#pragma unroll
                for (int ai = 0; ai < 2; ++ai)
#pragma unroll
                    for (int m = 0; m < 4; ++m) {
                        const int row = row0 + 128 * ai + 16 * m;
#pragma unroll
                        for (int bj = 0; bj < 2; ++bj) *(u32x4*)(C.PAB + (size_t)row * DM + 256 * pn + 128 * bj + lc8) = pk8(acc[ai][bj][m][0] * rstd[ai][m], acc[ai][bj][m][1] * rstd[ai][m]);
                    }
            } else if (pn < 8) {
                const bool isk = pn >= 6; const int head = 4 * (pn & 1) + wc;
                const float* gn = C.in[isk ? 19 : 18] + (size_t)l * 512 + 64 * head + 8 * fq;
                f32x4 gv[2][2];
#pragma unroll
                for (int bj = 0; bj < 2; ++bj)
#pragma unroll
                    for (int n = 0; n < 2; ++n) gv[bj][n] = *(const f32x4*)(gn + 32 * bj + 4 * n) * (isk ? 1.f : QSCALE);
#pragma unroll
                for (int ai = 0; ai < 2; ++ai)
#pragma unroll
                    for (int m = 0; m < 4; ++m) {
                        const int row = row0 + 128 * ai + 16 * m;
                        f32x4 v[2][2]; float ss = 0.f;
#pragma unroll
                        for (int bj = 0; bj < 2; ++bj)
#pragma unroll
                            for (int n = 0; n < 2; ++n) { v[bj][n] = acc[ai][bj][m][n] * rstd[ai][m]; ss += v[bj][n][0] * v[bj][n][0] + v[bj][n][1] * v[bj][n][1] + v[bj][n][2] * v[bj][n][2] + v[bj][n][3] * v[bj][n][3]; }
                        ss += __shfl_xor(ss, 16); ss += __shfl_xor(ss, 32);
                        const float rinv = __builtin_amdgcn_rsqf(ss * (1.f / 64.f) + RMS_EPS);
                        float* kdst = (float*)(C.PRE + (size_t)row * DM);
                        if (row < NPR) kdst = C.out + OFF_KP + ((size_t)l * NPR + row) * 512; else if (row < MR) kdst = C.out + OFF_KS + ((size_t)l * NSR + (row - NPR)) * 512;
                        bf16_t* bdst = (isk ? C.KP : C.Q) + (size_t)row * 512 + 64 * head + 8 * fq;
#pragma unroll
                        for (int bj = 0; bj < 2; ++bj) {
                            const f32x4 o0 = v[bj][0] * rinv * gv[bj][0], o1 = v[bj][1] * rinv * gv[bj][1];
                            *(u32x4*)(bdst + 32 * bj) = pk8(o0, o1);
                            if (isk) { *(f32x4*)(kdst + 64 * head + 8 * fq + 32 * bj) = o0; *(f32x4*)(kdst + 64 * head + 8 * fq + 32 * bj + 4) = o1; }
                        }
                    }
            } else if (pn < 10) {
#pragma unroll
                for (int ai = 0; ai < 2; ++ai)
#pragma unroll
                    for (int m = 0; m < 4; ++m) {
                        const int row = row0 + 128 * ai + 16 * m;
                        float* vdst = (float*)(C.PRE + (size_t)row * DM);
                        if (row < NPR) vdst = C.out + OFF_VP + ((size_t)l * NPR + row) * 512; else if (row < MR) vdst = C.out + OFF_VS + ((size_t)l * NSR + (row - NPR)) * 512;
                        const int b = row / TP, t = row - b * TP;
                        bf16_t* vt = C.VT + (size_t)b * 512 * LDV + 48 + t;
#pragma unroll
                        for (int bj = 0; bj < 2; ++bj)
#pragma unroll
                            for (int n = 0; n < 2; ++n) {
                                const int c512 = 256 * (pn - 8) + 128 * bj + lc8 + 4 * n;
                                const f32x4 o = acc[ai][bj][m][n] * rstd[ai][m];
                                *(f32x4*)(vdst + c512) = o;
                                const u32x2 p = pk4(o);
                                vt[(size_t)(c512 + 0) * LDV] = (bf16_t)(p.x & 0xffffu); vt[(size_t)(c512 + 1) * LDV] = (bf16_t)(p.x >> 16);
                                vt[(size_t)(c512 + 2) * LDV] = (bf16_t)(p.y & 0xffffu); vt[(size_t)(c512 + 3) * LDV] = (bf16_t)(p.y >> 16);
                            }
                    }
            } else {
                const int br = (pn - 10) >> 2, cb = 256 * ((pn - 10) & 3);
#pragma unroll
                for (int ai = 0; ai < 2; ++ai)
#pragma unroll
                    for (int m = 0; m < 4; ++m) {
                        const int row = row0 + 128 * ai + 16 * m;
#pragma unroll
                        for (int bj = 0; bj < 2; ++bj) {
                            f32x4 sg[2];
#pragma unroll
                            for (int n = 0; n < 2; ++n) {
                                const f32x4 x = acc[ai][bj][m][n] * rstd[ai][m];
#pragma unroll
                                for (int i = 0; i < 4; ++i) sg[n][i] = sigmoidf_(x[i]);
                            }
                            *(u32x4*)(C.G + (size_t)row * 3072 + br * 1024 + cb + 128 * bj + lc8) = pk8(sg[0], sg[1]);
                        }
                    }
            }
        }
    } else if (K == EK_RESID) {
#pragma unroll
        for (int ai = 0; ai < 2; ++ai)
#pragma unroll
        for (int mh = 0; mh < 2; ++mh) {
            u32x4 h[2][2];
#pragma unroll
            for (int m2 = 0; m2 < 2; ++m2)
#pragma unroll
                for (int bj = 0; bj < 2; ++bj) h[m2][bj] = *(const u32x4*)(C.XB + (size_t)(row0 + 128 * ai + 16 * (2 * mh + m2)) * DM + 256 * u.pn + 128 * bj + lc8);
#pragma unroll
            for (int m2 = 0; m2 < 2; ++m2) {
                const int m = 2 * mh + m2;
                const int row = row0 + 128 * ai + 16 * m;
                float* dst = C.PA + (size_t)row * DM;
                if (E.final_) {
                    if (row < NPR) { const int b = row / TP, t = row - b * TP; if (t >= 16) dst = C.out + OFF_YP + ((size_t)b * 4096 + (t - 16)) * 1024; }
                    else if (row < MR) dst = C.out + OFF_YS + (size_t)(row - NPR) * 1024;
                }
                float ss = 0.f;
#pragma unroll
                for (int bj = 0; bj < 2; ++bj) {
                    const int col = 256 * u.pn + 128 * bj + lc8;
                    const f32x4 hv0 = unpk4((u32x2){h[m2][bj].x, h[m2][bj].y}) + acc[ai][bj][m][0] * E.alpha, hv1 = unpk4((u32x2){h[m2][bj].z, h[m2][bj].w}) + acc[ai][bj][m][1] * E.alpha;
                    if (E.final_) { *(f32x4*)(dst + col) = hv0; *(f32x4*)(dst + col + 4) = hv1; }
                    else {
                        *(u32x4*)(C.XB + (size_t)row * DM + col) = pk8(hv0, hv1);
                        ss += hv0[0] * hv0[0] + hv0[1] * hv0[1] + hv0[2] * hv0[2] + hv0[3] * hv0[3] + hv1[0] * hv1[0] + hv1[1] * hv1[1] + hv1[2] * hv1[2] + hv1[3] * hv1[3];
                    }
                }
                if (!E.final_) {
                    ss += __shfl_xor(ss, 16); ss += __shfl_xor(ss, 32);
                    if (fq == 0) unsafeAtomicAdd(E.rss_out + row, ss);
                }
            }
        }
    } else {
        const int seg = u.seg;
#pragma unroll
        for (int ai = 0; ai < 2; ++ai)
#pragma unroll
        for (int mh = 0; mh < 2; ++mh) {
            u32x4 gq[2][2], mf[2][2];
#pragma unroll
            for (int m2 = 0; m2 < 2; ++m2)
#pragma unroll
                for (int bj = 0; bj < 2; ++bj) {
                    const int row = row0 + 128 * ai + 16 * (2 * mh + m2), col = 256 * u.pn + 128 * bj + lc8;
                    gq[m2][bj] = *(const u32x4*)(C.G + (size_t)row * 3072 + seg * 1024 + col);
                    if (seg > 0) mf[m2][bj] = *(const u32x4*)(C.MIXB + (size_t)row * DM + col); else mf[m2][bj] = (u32x4){0u, 0u, 0u, 0u};
                }
#pragma unroll
            for (int m2 = 0; m2 < 2; ++m2)
#pragma unroll
                for (int bj = 0; bj < 2; ++bj) {
                    const int m = 2 * mh + m2;
                    const int row = row0 + 128 * ai + 16 * m, col = 256 * u.pn + 128 * bj + lc8;
                    const f32x4 r0 = acc[ai][bj][m][0] * unpk4((u32x2){gq[m2][bj].x, gq[m2][bj].y}) + unpk4((u32x2){mf[m2][bj].x, mf[m2][bj].y});
                    const f32x4 r1 = acc[ai][bj][m][1] * unpk4((u32x2){gq[m2][bj].z, gq[m2][bj].w}) + unpk4((u32x2){mf[m2][bj].z, mf[m2][bj].w});
                    *(u32x4*)(C.MIXB + (size_t)row * DM + col) = pk8(r0, r1);
                }
        }
    }
}

template <bool PERM>
__device__ __forceinline__ void gemm_phase(LAS unsigned char* lds, const Gemm g, const Sched& S, const EpiDesc& E, const Ctx& C) {
    const int tid = opaque_tid(), wid = __builtin_amdgcn_readfirstlane(tid >> 6), lane = tid & 63, wr = wid >> 2, wc = wid & 3, fr = lane & 15, fq = lane >> 4;
    unsigned voffA[2], voffB[2];
#pragma unroll
    for (int i = 0; i < 2; ++i) { int R, Cc; stage_rc(tid * 16 + i * 8192, R, Cc); const int Rb = PERM ? (R & ~31) + perm32(R & 31) : R; voffA[i] = (unsigned)(R * g.lda + Cc) * 2u; voffB[i] = (unsigned)(Rb * g.ldb + Cc) * 2u; }
    const size_t kstep = (size_t)(BK * 2);
    const size_t hstepA = (size_t)HALF * g.lda * 2, hstepB = (size_t)HALF * g.ldb * 2;
    const size_t tstepA = 2 * hstepA, tstepB = 2 * hstepB;
    const unsigned ldsw = (unsigned)wid * 1024u;
    const int aoff = lds_byte(wr * 64 + fr, fq * 8), boff = lds_byte(wc * 32 + fr, fq * 8);
#define PG8_SA(b, h) (((b) * 2 + (h)) * HTB)
#define PG8_SB(b, h) ((4 + (b) * 2 + (h)) * HTB)
#define PG8_STAGE(bufoff, gbase, voff) do { _Pragma("unroll") for (int _i = 0; _i < 2; ++_i) \
        __builtin_amdgcn_global_load_lds((const unsigned*)((const char*)(gbase) + (voff)[_i]), (LAS unsigned*)(lds + (bufoff) + ldsw + _i * 8192), 16, 0, 0); } while (0)
#define PG8_LDA(dst, b, h) do { _Pragma("unroll") for (int m = 0; m < 4; ++m) _Pragma("unroll") for (int k = 0; k < 2; ++k) dst[m][k] = *(const LAS bf16x8*)(lds + PG8_SA(b, h) + aoff + m * 2048 + k * 1024); } while (0)
#define PG8_LDB(dst, b, h) do { _Pragma("unroll") for (int n = 0; n < 2; ++n) _Pragma("unroll") for (int k = 0; k < 2; ++k) dst[n][k] = *(const LAS bf16x8*)(lds + PG8_SB(b, h) + boff + n * 2048 + k * 1024); } while (0)
#define PG8_MMA(ai, bj, At, Bt) do { __builtin_amdgcn_s_setprio(1); _Pragma("unroll") for (int m = 0; m < 4; ++m) _Pragma("unroll") for (int n = 0; n < 2; ++n) _Pragma("unroll") for (int k = 0; k < 2; ++k) \
        acc[ai][bj][m][n] = __builtin_amdgcn_mfma_f32_16x16x32_bf16(Bt[n][k], At[m][k], acc[ai][bj][m][n], 0, 0, 0); __builtin_amdgcn_s_setprio(0); } while (0)
#define PG8_WAIT_V(n) asm volatile("s_waitcnt vmcnt(" #n ")" ::: "memory")
#define PG8_WAIT_L(n) asm volatile("s_waitcnt lgkmcnt(" #n ")" ::: "memory")
#define PG8_BAR __builtin_amdgcn_s_barrier()
#define PG8_SCHED __builtin_amdgcn_sched_barrier(0)
    Unit cur, nxt; int ui = 0;
    if (!S.next(0, cur)) return;
    f32x4 acc[2][2][4][2];
#pragma unroll
    for (int a = 0; a < 2; ++a)
#pragma unroll
        for (int b = 0; b < 2; ++b)
#pragma unroll
            for (int m = 0; m < 4; ++m)
#pragma unroll
                for (int n = 0; n < 2; ++n) acc[a][b][m][n] = (f32x4){0.f, 0.f, 0.f, 0.f};
    bf16x8 At[4][2], B0[2][2], B1[2][2];
    const char* cA = (const char*)g.A + (size_t)cur.pm * tstepA + (size_t)cur.kofs * 2; const char* cB = (const char*)g.Bt + (size_t)cur.pn * tstepB + (size_t)cur.kofs * 2;
    PG8_STAGE(PG8_SB(0, 0), cB, voffB); PG8_STAGE(PG8_SB(0, 1), cB + hstepB, voffB); PG8_STAGE(PG8_SA(0, 0), cA, voffA); PG8_STAGE(PG8_SA(0, 1), cA + hstepA, voffA);
    if (wr == 1) PG8_BAR;
    PG8_WAIT_V(2); PG8_BAR;
    PG8_STAGE(PG8_SB(1, 0), cB + kstep, voffB); PG8_STAGE(PG8_SA(1, 0), cA + kstep, voffA); PG8_STAGE(PG8_SB(1, 1), cB + hstepB + kstep, voffB);
    PG8_WAIT_V(6); PG8_BAR;
    for (;;) {
        const bool has_next = S.next(ui + 1, nxt);
        const char* nA = has_next ? (const char*)g.A + (size_t)nxt.pm * tstepA + (size_t)nxt.kofs * 2 : cA; const char* nB = has_next ? (const char*)g.Bt + (size_t)nxt.pn * tstepB + (size_t)nxt.kofs * 2 : cB;
        const int nt = cur.nt;
        for (int t = 0; t < nt; t += 2) {
            const bool last = (t == nt - 2);
            const char* a1 = cA + (size_t)(t + 1) * kstep;
            const char* a2 = last ? nA : cA + (size_t)(t + 2) * kstep; const char* b2 = last ? nB : cB + (size_t)(t + 2) * kstep;
            const char* a3 = a2 + kstep; const char* b3 = b2 + kstep;
            PG8_LDB(B0, 0, 0); PG8_LDB(B1, 0, 1); PG8_SCHED; PG8_LDA(At, 0, 0); PG8_STAGE(PG8_SA(1, 1), a1 + hstepA, voffA);
            PG8_WAIT_V(8); PG8_WAIT_L(0); PG8_BAR; PG8_MMA(0, 0, At, B0); PG8_MMA(0, 1, At, B1); PG8_BAR; PG8_SCHED;
            PG8_LDA(At, 0, 1); PG8_STAGE(PG8_SB(0, 0), b2, voffB); PG8_STAGE(PG8_SB(0, 1), b2 + hstepB, voffB); PG8_STAGE(PG8_SA(0, 0), a2, voffA);
            PG8_WAIT_V(8); PG8_WAIT_L(0); PG8_BAR; PG8_MMA(1, 0, At, B0); PG8_MMA(1, 1, At, B1); PG8_BAR; PG8_SCHED;
            PG8_LDB(B0, 1, 0); PG8_LDB(B1, 1, 1); PG8_SCHED; PG8_LDA(At, 1, 0); PG8_STAGE(PG8_SA(0, 1), a2 + hstepA, voffA);
            PG8_WAIT_V(8); PG8_WAIT_L(0); PG8_BAR; PG8_MMA(0, 0, At, B0); PG8_MMA(0, 1, At, B1); PG8_BAR; PG8_SCHED;
            PG8_LDA(At, 1, 1); PG8_STAGE(PG8_SB(1, 0), b3, voffB); PG8_STAGE(PG8_SB(1, 1), b3 + hstepB, voffB); PG8_STAGE(PG8_SA(1, 0), a3, voffA);
            PG8_WAIT_V(8); PG8_WAIT_L(0); PG8_BAR; PG8_MMA(1, 0, At, B0); PG8_MMA(1, 1, At, B1); PG8_BAR; PG8_SCHED;
        }
        if (wr == 0) PG8_BAR;
        if (PERM) {
            if ((PERM_MASK & 1) && E.kind == EK_SWIGLU) epilogue_p<EK_SWIGLU>(acc, cur, E, C, wr, wc, fr, fq);
            else if ((PERM_MASK & 2) && E.kind == EK_RESID) epilogue_p<EK_RESID>(acc, cur, E, C, wr, wc, fr, fq);
            else if ((PERM_MASK & 4) && E.kind == EK_PROJ) epilogue_p<EK_PROJ>(acc, cur, E, C, wr, wc, fr, fq);
            else if ((PERM_MASK & 8) && E.kind == EK_BRANCH) epilogue_p<EK_BRANCH>(acc, cur, E, C, wr, wc, fr, fq);
        } else {
            if (!(PERM_MASK & 1) && E.kind == EK_SWIGLU) epilogue<EK_SWIGLU>(acc, cur, E, C, wr, wc, fr, fq);
            else if (!(PERM_MASK & 2) && E.kind == EK_RESID) epilogue<EK_RESID>(acc, cur, E, C, wr, wc, fr, fq);
            else if (!(PERM_MASK & 4) && E.kind == EK_PROJ) epilogue<EK_PROJ>(acc, cur, E, C, wr, wc, fr, fq);
            else if (!(PERM_MASK & 8) && E.kind == EK_BRANCH) epilogue<EK_BRANCH>(acc, cur, E, C, wr, wc, fr, fq);
        }
        if (!has_next) break;
#pragma unroll
        for (int a = 0; a < 2; ++a)
#pragma unroll
            for (int b = 0; b < 2; ++b)
#pragma unroll
                for (int m = 0; m < 4; ++m)
#pragma unroll
                    for (int n = 0; n < 2; ++n) acc[a][b][m][n] = (f32x4){0.f, 0.f, 0.f, 0.f};
        cur = nxt; cA = nA; cB = nB; ++ui;
        if (wr == 1) PG8_BAR;
    }
    PG8_WAIT_V(0);
    PG8_BAR;
#undef PG8_SA
#undef PG8_SB
#undef PG8_STAGE
#undef PG8_LDA
#undef PG8_LDB
#undef PG8_MMA
#undef PG8_WAIT_V
#undef PG8_WAIT_L
#undef PG8_BAR
#undef PG8_SCHED
}
__device__ __forceinline__ void small_unit(const Gemm g, const EpiDesc& E, const Ctx& C, int su, unsigned char* shm) {
    const int tid = opaque_tid(), lane = tid & 63, w = __builtin_amdgcn_readfirstlane(tid >> 6), m = lane & 31, hi = lane >> 5;
    const int row0 = 16384 + 64 * (su >> 4), col0 = 64 * (su & 15);
    int k_lo, k_len;
    if (E.kind == EK_BRANCH) { k_len = 128; k_lo = 128 * w; }
    else { k_len = (E.kind == EK_RESID && g.lda == DFF) ? DFF / 8 : DM / 8; k_lo = k_len * w; }
    const bf16_t* ap = g.A + (size_t)(row0 + m) * g.lda + k_lo + 8 * hi;
    const bf16_t* bp = g.Bt + (size_t)(col0 + m) * g.ldb + k_lo + 8 * hi;
    const size_t a32 = (size_t)32 * g.lda, b32 = (size_t)32 * g.ldb;
    f32x16 acc[2][2];
#pragma unroll
    for (int i = 0; i < 2; ++i)
#pragma unroll
        for (int j = 0; j < 2; ++j)
#pragma unroll
            for (int r = 0; r < 16; ++r) acc[i][j][r] = 0.f;
    const int nsteps = k_len >> 5;
    for (int s0 = 0; s0 < nsteps; s0 += 4) {
        bf16x8 fa[4][4], fb[4][4];
#pragma unroll
        for (int u = 0; u < 4; ++u) {
            const int k = 32 * min(s0 + u, nsteps - 1);
            fa[u][0] = *(const bf16x8*)(ap + k); fa[u][1] = *(const bf16x8*)(ap + a32 + k); fa[u][2] = *(const bf16x8*)(ap + k + 16); fa[u][3] = *(const bf16x8*)(ap + a32 + k + 16);
            fb[u][0] = *(const bf16x8*)(bp + k); fb[u][1] = *(const bf16x8*)(bp + b32 + k); fb[u][2] = *(const bf16x8*)(bp + k + 16); fb[u][3] = *(const bf16x8*)(bp + b32 + k + 16);
        }
#pragma unroll
        for (int u = 0; u < 4; ++u) {
            if (s0 + u < nsteps) {
                acc[0][0] = __builtin_amdgcn_mfma_f32_32x32x16_bf16(fa[u][0], fb[u][0], acc[0][0], 0, 0, 0); acc[0][1] = __builtin_amdgcn_mfma_f32_32x32x16_bf16(fa[u][0], fb[u][1], acc[0][1], 0, 0, 0);
                acc[1][0] = __builtin_amdgcn_mfma_f32_32x32x16_bf16(fa[u][1], fb[u][0], acc[1][0], 0, 0, 0); acc[1][1] = __builtin_amdgcn_mfma_f32_32x32x16_bf16(fa[u][1], fb[u][1], acc[1][1], 0, 0, 0);
                acc[0][0] = __builtin_amdgcn_mfma_f32_32x32x16_bf16(fa[u][2], fb[u][2], acc[0][0], 0, 0, 0); acc[0][1] = __builtin_amdgcn_mfma_f32_32x32x16_bf16(fa[u][2], fb[u][3], acc[0][1], 0, 0, 0);
                acc[1][0] = __builtin_amdgcn_mfma_f32_32x32x16_bf16(fa[u][3], fb[u][2], acc[1][0], 0, 0, 0); acc[1][1] = __builtin_amdgcn_mfma_f32_32x32x16_bf16(fa[u][3], fb[u][3], acc[1][1], 0, 0, 0);
            }
        }
    }
    float* P = (float*)shm + w * 4096;
#pragma unroll
    for (int i = 0; i < 2; ++i)
#pragma unroll
        for (int j = 0; j < 2; ++j)
#pragma unroll
            for (int r = 0; r < 16; ++r) P[(32 * i + crow(r, hi)) * 64 + 32 * j + m] = acc[i][j][r];
    __syncthreads();
    {
        const int r = tid >> 3, cg8 = (tid & 7) * 8, row = row0 + r, col = col0 + cg8;
        const float* pp = (const float*)shm + r * 64 + cg8;
        f32x4 v0, v1;
        if (E.kind == EK_BRANCH) {
            const bf16_t* gp = C.G + (size_t)row * 3072 + col;
            f32x4 s0 = *(const f32x4*)(pp) + *(const f32x4*)(pp + 4096), s1 = *(const f32x4*)(pp + 4) + *(const f32x4*)(pp + 4096 + 4);
            f32x4 t0 = *(const f32x4*)(pp + 2 * 4096) + *(const f32x4*)(pp + 3 * 4096), t1 = *(const f32x4*)(pp + 2 * 4096 + 4) + *(const f32x4*)(pp + 3 * 4096 + 4);
            f32x4 u0 = (*(const f32x4*)(pp + 4 * 4096) + *(const f32x4*)(pp + 5 * 4096)) + (*(const f32x4*)(pp + 6 * 4096) + *(const f32x4*)(pp + 7 * 4096));
            f32x4 u1 = (*(const f32x4*)(pp + 4 * 4096 + 4) + *(const f32x4*)(pp + 5 * 4096 + 4)) + (*(const f32x4*)(pp + 6 * 4096 + 4) + *(const f32x4*)(pp + 7 * 4096 + 4));
            const u32x4 ga = *(const u32x4*)(gp), gb = *(const u32x4*)(gp + 1024), gc = *(const u32x4*)(gp + 2048);
            v0 = s0 * unpk4((u32x2){ga.x, ga.y}) + t0 * unpk4((u32x2){gb.x, gb.y}) + u0 * unpk4((u32x2){gc.x, gc.y});
            v1 = s1 * unpk4((u32x2){ga.z, ga.w}) + t1 * unpk4((u32x2){gb.z, gb.w}) + u1 * unpk4((u32x2){gc.z, gc.w});
            const u32x2 p0 = pk4(v0), p1 = pk4(v1);
            *(u32x4*)(C.MIXB + (size_t)row * DM + col) = (u32x4){p0.x, p0.y, p1.x, p1.y};
        } else {
            v0 = (f32x4){0.f, 0.f, 0.f, 0.f}; v1 = v0;
#pragma unroll
            for (int ww = 0; ww < 8; ++ww) { v0 = v0 + *(const f32x4*)(pp + ww * 4096); v1 = v1 + *(const f32x4*)(pp + ww * 4096 + 4); }
            const u32x4 hb = *(const u32x4*)(C.XB + (size_t)row * DM + col);
            const f32x4 h0 = unpk4((u32x2){hb.x, hb.y}) + v0 * E.alpha, h1 = unpk4((u32x2){hb.z, hb.w}) + v1 * E.alpha;
            const u32x2 p0 = pk4(h0), p1 = pk4(h1);
            if (!E.final_) *(u32x4*)(C.XB + (size_t)row * DM + col) = (u32x4){p0.x, p0.y, p1.x, p1.y};
            if (E.final_) {
                float* dst = nullptr;
                if (row < NPR) { const int b = row / TP, t = row - b * TP; if (t >= 16) dst = C.out + OFF_YP + ((size_t)b * 4096 + (t - 16)) * 1024; }
                else dst = C.out + OFF_YS + (size_t)(row - NPR) * 1024;
                if (dst) { *(f32x4*)(dst + col) = h0; *(f32x4*)(dst + col + 4) = h1; }
            }
            float ss = h0[0] * h0[0] + h0[1] * h0[1] + h0[2] * h0[2] + h0[3] * h0[3] + h1[0] * h1[0] + h1[1] * h1[1] + h1[2] * h1[2] + h1[3] * h1[3];
            ss += __shfl_xor(ss, 1); ss += __shfl_xor(ss, 2); ss += __shfl_xor(ss, 4);
            if ((tid & 7) == 0) unsafeAtomicAdd(E.rss_out + row, ss);
        }
    }
    __syncthreads();
}
}

__device__ __forceinline__ float wave_sum(float v) {
#pragma unroll
    for (int o = 1; o < 64; o <<= 1) v += __shfl_xor(v, o);
    return v;
}
__device__ __forceinline__ const float* src_col(int kind, const float* W, const float* W2, int c) {
    if (kind == 1) { if (PERM_MASK & 1) { const int pn = c >> 8, sl = c & 255; return ((sl >> 7) ? W2 : W) + 128 * pn + (sl & 127); } const int Gc = c >> 5, n = (c >> 4) & 1, i = c & 15; return (n ? W2 : W) + 16 * Gc + i; }
    if (kind == 2) { const int pn = c >> 8; if (pn >= 4 && pn < 8) { const int s = c & 255, hl = (s >> 5) & 3, d = 32 * (s >> 7) + (s & 31); return W + 256 * pn + 64 * hl + d; } return W + c; }
    return W + c;
}
struct ItemP { const float* p; const float* gain; bf16_t* wt; int srcN, ldt, k0; };
__device__ __forceinline__ void item_set(ItemP& P, int kind, const float* W, const float* W2, int srcN, const float* gain, bf16_t* WT, int ldt, int kb, int cb, int lane) {
    const int k0 = 64 * kb, c0 = 64 * cb, c4 = (lane & 15) * 4, kr = lane >> 4;
    P.p = src_col(kind, W, W2, c0 + c4) + (size_t)(k0 + kr) * srcN; P.gain = gain; P.wt = WT + (size_t)c0 * ldt + k0; P.srcN = srcN; P.ldt = ldt; P.k0 = k0;
}
constexpr int I_GU = 16 * 88, I_DN = 44 * 16, I_IN = 16 * 88, I_BP = 4 * 16, I_BA = 8 * 16, I_OUT = 16 * 16;
constexpr int I_LAYER = 2 * I_GU + 2 * I_DN + I_IN + 2 * I_BP + I_BA + I_OUT;
__device__ __forceinline__ void item_params(const Ctx& C, int it, int lane, ItemP& P) {
    const int l = it / I_LAYER; int r = it - l * I_LAYER;
    unsigned char* wl = C.ws + WS_W + (size_t)l * W_LAYER;
    if (r < I_GU) { item_set(P, 1, C.in[8] + (size_t)l * DM * DFF, C.in[9] + (size_t)l * DM * DFF, DFF, C.in[7] + l * DM, (bf16_t*)(wl + W_GU1), DM, r / 88, r % 88, lane); return; } r -= I_GU;
    if (r < I_GU) { item_set(P, 1, C.in[23] + (size_t)l * DM * DFF, C.in[24] + (size_t)l * DM * DFF, DFF, C.in[22] + l * DM, (bf16_t*)(wl + W_GU2), DM, r / 88, r % 88, lane); return; } r -= I_GU;
    if (r < I_DN) { item_set(P, 0, C.in[10] + (size_t)l * DFF * DM, nullptr, DM, nullptr, (bf16_t*)(wl + W_DN1), DFF, r / 16, r % 16, lane); return; } r -= I_DN;
    if (r < I_DN) { item_set(P, 0, C.in[25] + (size_t)l * DFF * DM, nullptr, DM, nullptr, (bf16_t*)(wl + W_DN2), DFF, r / 16, r % 16, lane); return; } r -= I_DN;
    if (r < I_IN) { item_set(P, 2, C.in[12] + (size_t)l * DM * NIN, nullptr, NIN, C.in[11] + l * DM, (bf16_t*)(wl + W_IN), DM, r / 88, r % 88, lane); return; } r -= I_IN;
    if (r < I_BP) { item_set(P, 0, C.in[15] + (size_t)l * 256 * DM, nullptr, DM, nullptr, (bf16_t*)(wl + W_BR), DM, r / 16, r % 16, lane); return; } r -= I_BP;
    if (r < I_BP) { item_set(P, 0, C.in[17] + (size_t)l * 256 * DM, nullptr, DM, nullptr, (bf16_t*)(wl + W_BR) + 256, DM, r / 16, r % 16, lane); return; } r -= I_BP;
    if (r < I_BA) { item_set(P, 0, C.in[20] + (size_t)l * 512 * DM, nullptr, DM, nullptr, (bf16_t*)(wl + W_BR) + 512, DM, r / 16, r % 16, lane); return; } r -= I_BA;
    item_set(P, 0, C.in[21] + (size_t)l * DM * DM, nullptr, DM, nullptr, (bf16_t*)(wl + W_OUT), DM, r / 16, r % 16, lane);
}
__device__ __forceinline__ void convert_items(const Ctx& C, unsigned char* shm, int it_lo, int it_hi, int gw0, int ngw) {
    const int tid = opaque_tid(), lane = tid & 63, wave = tid >> 6;
    float* scr = (float*)(shm + wave * 16640);
    const int c4 = (lane & 15) * 4, kr = lane >> 4, c8 = lane & 7;
    int it = it_lo + gw0;
    if (it >= it_hi) return;
    ItemP P; item_params(C, it, lane, P);
    f32x4 v[16];
#pragma unroll
    for (int i = 0; i < 16; ++i) v[i] = *(const f32x4*)(P.p + (size_t)(4 * i) * P.srcN);
    for (;;) {
#pragma unroll
        for (int i = 0; i < 16; ++i) {
            const int kk = 4 * i + kr; const float gs = P.gain ? P.gain[P.k0 + kk] : 1.f;
            float* d = scr + kk * 65 + c4;
            d[0] = v[i][0] * gs; d[1] = v[i][1] * gs; d[2] = v[i][2] * gs; d[3] = v[i][3] * gs;
        }
        const int nx = it + ngw; const bool has = nx < it_hi;
        ItemP Pn = P;
        if (has) {
            item_params(C, nx, lane, Pn);
#pragma unroll
            for (int i = 0; i < 16; ++i) v[i] = *(const f32x4*)(Pn.p + (size_t)(4 * i) * Pn.srcN);
        }
        asm volatile("s_waitcnt lgkmcnt(0)" ::: "memory");
#pragma unroll
        for (int j = 0; j < 8; ++j) { const int n = (lane >> 3) + 8 * j; const float* s = scr + (8 * c8) * 65 + n;
            u32x4 o; o.x = cvt_pk_bf16(s[0 * 65], s[1 * 65]); o.y = cvt_pk_bf16(s[2 * 65], s[3 * 65]); o.z = cvt_pk_bf16(s[4 * 65], s[5 * 65]); o.w = cvt_pk_bf16(s[6 * 65], s[7 * 65]);
            *(u32x4*)(P.wt + (size_t)n * P.ldt + 8 * c8) = o; }
        asm volatile("s_waitcnt lgkmcnt(0)" ::: "memory");
        if (!has) break;
        it = nx; P = Pn;
    }
}

__device__ __forceinline__ void prologue_phase(const Ctx& C, unsigned char* shm) {
    const int tid = opaque_tid(), lane = tid & 63, wave = tid >> 6;
    const int gw = blockIdx.x * 8 + wave, NGW = gridDim.x * 8;
    convert_items(C, shm, 0, (gridDim.x > 160) ? I_LAYER : 2 * I_LAYER, gw, NGW);
    for (int m0 = gw; m0 < MP; m0 += 4 * NGW) {
        f32x4 v[4][4];
#pragma unroll
        for (int u = 0; u < 4; ++u) {
            const int m = m0 + u * NGW;
            const float* src = C.in[6];
            if (m < NPR) { const int b = m / TP, t = m - b * TP; src = (t < 16) ? C.in[6] + (size_t)t * DM : C.in[0] + ((size_t)b * 4096 + (t - 16)) * DM; }
            else if (m < MR) src = C.in[1] + (size_t)(m - NPR) * DM;
#pragma unroll
            for (int j = 0; j < 4; ++j) v[u][j] = *((const f32x4*)src + lane + 64 * j);
        }
#pragma unroll
        for (int u = 0; u < 4; ++u) {
            const int m = m0 + u * NGW;
            if (m < MP) {
                float s = 0.f;
#pragma unroll
                for (int j = 0; j < 4; ++j) { f32x4 x = v[u][j]; if (m >= MR) x = (f32x4){0.f, 0.f, 0.f, 0.f};
                    s += x[0] * x[0] + x[1] * x[1] + x[2] * x[2] + x[3] * x[3];
                    *((u32x2*)(C.XB + (size_t)m * DM) + lane + 64 * j) = pk4(x); }
                s = wave_sum(s);
                if (lane == 0) C.RSS[m] = s;
                if (lane >= 1 && lane < 7) C.RSS[(size_t)lane * MP + m] = 0.f;
            }
        }
    }
}

typedef float f32x2 __attribute__((ext_vector_type(2)));
template <bool MASK>
__device__ __forceinline__ void sb_math(const f32x16& st, int kb, int tq, int hi, float& carry, bf16x8& p0, bf16x8& p1) {
    f32x2 e2[8], x2[8];
#pragma unroll
    for (int p = 0; p < 8; ++p) {
        float e0 = __builtin_amdgcn_exp2f(st[2 * p]), e1 = __builtin_amdgcn_exp2f(st[2 * p + 1]);
        if (MASK) { const int key = kb + crow(2 * p, hi); e0 = (key >= 0 && key < tq) ? e0 : 0.f; e1 = (key + 1 >= 0 && key + 1 < tq) ? e1 : 0.f; }
        e2[p] = (f32x2){e0, e1};
        const f32x2 d = e2[p] + (f32x2){1.f, 1.f};
        x2[p] = (f32x2){__builtin_amdgcn_rcpf(d.x), __builtin_amdgcn_rcpf(d.y)};
    }
    float g0[4], g1[4];
#pragma unroll
    for (int c = 0; c < 4; ++c) {
        const float X3 = x2[2 * c + 1].y, X2 = x2[2 * c + 1].x * X3, X1 = x2[2 * c].y * X2, X0 = x2[2 * c].x * X1;
        x2[2 * c] = (f32x2){X0, X1}; x2[2 * c + 1] = (f32x2){X2, X3};
        auto rr = __builtin_amdgcn_permlane32_swap(__float_as_uint(X0), __float_as_uint(X0), false, false);
        g0[c] = __uint_as_float(rr[0]); g1[c] = __uint_as_float(rr[1]);
    }
    const float T7 = carry, T6 = T7 * g1[3], T5 = T6 * g0[3], T4 = T5 * g1[2], T3 = T4 * g0[2], T2 = T3 * g1[1], T1 = T2 * g0[1], T0 = T1 * g1[0];
    carry = T0 * g0[0];
    const float t0 = hi ? T1 : T0, t1 = hi ? T3 : T2, t2 = hi ? T5 : T4, t3 = hi ? T7 : T6;
    f32x2 a2[8];
    { const f32x2 tb = (f32x2){t0, t0}; a2[0] = e2[0] * (x2[0] * tb); a2[1] = e2[1] * (x2[1] * tb); }
    { const f32x2 tb = (f32x2){t1, t1}; a2[2] = e2[2] * (x2[2] * tb); a2[3] = e2[3] * (x2[3] * tb); }
    { const f32x2 tb = (f32x2){t2, t2}; a2[4] = e2[4] * (x2[4] * tb); a2[5] = e2[5] * (x2[5] * tb); }
    { const f32x2 tb = (f32x2){t3, t3}; a2[6] = e2[6] * (x2[6] * tb); a2[7] = e2[7] * (x2[7] * tb); }
    u32x4 q0, q1;
    q0.x = cvt_pk_bf16(a2[0].x, a2[0].y); q0.y = cvt_pk_bf16(a2[1].x, a2[1].y); q0.z = cvt_pk_bf16(a2[2].x, a2[2].y); q0.w = cvt_pk_bf16(a2[3].x, a2[3].y);
    q1.x = cvt_pk_bf16(a2[4].x, a2[4].y); q1.y = cvt_pk_bf16(a2[5].x, a2[5].y); q1.z = cvt_pk_bf16(a2[6].x, a2[6].y); q1.w = cvt_pk_bf16(a2[7].x, a2[7].y);
    p0 = __builtin_bit_cast(bf16x8, q0); p1 = __builtin_bit_cast(bf16x8, q1);
}

constexpr int AT_KROW = 144, AT_VROW = 136, AT_KBYTES = 64 * AT_KROW, AT_BUF = AT_KBYTES + 64 * AT_VROW;

__device__ __forceinline__ void attn_main_unit(const Ctx& C, int b, int h, int j, unsigned char* shm) {
    const int tid = opaque_tid(), lane = tid & 63, qi = lane & 31, hi = lane >> 5, w = __builtin_amdgcn_readfirstlane(tid >> 6);
    const int tq0 = 16 + 256 * j + 32 * w, tq = tq0 + qi;
    const size_t qrow = (size_t)b * TP + tq;
    bf16x8 qf[4];
#pragma unroll
    for (int s = 0; s < 4; ++s) qf[s] = *(const bf16x8*)(C.Q + qrow * 512 + 64 * h + 16 * s + 8 * hi);
    f32x16 o0, o1;
#pragma unroll
    for (int r = 0; r < 16; ++r) { o0[r] = 0.f; o1[r] = 0.f; }
    float carry = 1.f;
    const int itop = 4 * j + 4, wtop = 4 * j + (32 * w + 94) / 64;
    const int srow = tid >> 3, sch = tid & 7;
    const bf16_t* kg = C.KP + ((ptrdiff_t)b * TP - 48 + srow) * 512 + 64 * h + 8 * sch;
    const bf16_t* vg = C.VB + ((ptrdiff_t)b * TP - 48 + srow) * 512 + 64 * h + 8 * sch;
    u32x4 kreg = *(const u32x4*)(kg + (size_t)itop * 64 * 512), vreg = *(const u32x4*)(vg + (size_t)itop * 64 * 512);
    unsigned* flg = (unsigned*)(shm + 2 * AT_BUF);
    if (tid < 2) flg[tid] = 0u;
    bool wdone = false;
    for (int i = itop; i >= 0; --i) {
        unsigned char* kb_ = shm + (i & 1) * AT_BUF; unsigned char* vb_ = kb_ + AT_KBYTES;
        *(u32x4*)(kb_ + srow * AT_KROW + sch * 16) = kreg;
        {
            bf16_t* vw = (bf16_t*)(vb_ + (8 * sch) * AT_VROW + srow * 2);
            vw[0 * (AT_VROW / 2)] = (bf16_t)(vreg.x & 0xffffu); vw[1 * (AT_VROW / 2)] = (bf16_t)(vreg.x >> 16);
            vw[2 * (AT_VROW / 2)] = (bf16_t)(vreg.y & 0xffffu); vw[3 * (AT_VROW / 2)] = (bf16_t)(vreg.y >> 16);
            vw[4 * (AT_VROW / 2)] = (bf16_t)(vreg.z & 0xffffu); vw[5 * (AT_VROW / 2)] = (bf16_t)(vreg.z >> 16);
            vw[6 * (AT_VROW / 2)] = (bf16_t)(vreg.w & 0xffffu); vw[7 * (AT_VROW / 2)] = (bf16_t)(vreg.w >> 16);
        }
        if (i > 0) { kreg = *(const u32x4*)(kg + (size_t)(i - 1) * 64 * 512); vreg = *(const u32x4*)(vg + (size_t)(i - 1) * 64 * 512); }
        asm volatile("s_waitcnt lgkmcnt(0)" ::: "memory"); __builtin_amdgcn_s_barrier(); asm volatile("" ::: "memory");
        if (i < itop) { const unsigned fw = (unsigned)__builtin_amdgcn_readfirstlane((int)((volatile unsigned*)flg)[(i + 1) & 1]); if (fw == 0xFFu) break; }
        if (i <= wtop && !wdone) {
#pragma unroll
            for (int sub = 1; sub >= 0; --sub) {
                const int kb = 64 * i - 48 + 32 * sub;
                if (kb > tq0 + 30 || kb + 31 < 0) continue;
                const bool need_mask = (kb + 31 >= tq0) || (kb < 0);
                f32x16 st;
#pragma unroll
                for (int r = 0; r < 16; ++r) st[r] = 0.f;
#pragma unroll
                for (int s = 0; s < 4; ++s) { const bf16x8 kf = *(const bf16x8*)(kb_ + (32 * sub + qi) * AT_KROW + 32 * s + 16 * hi); st = __builtin_amdgcn_mfma_f32_32x32x16_bf16(kf, qf[s], st, 0, 0, 0); }
                bf16x8 p0, p1;
                if (need_mask) sb_math<true>(st, kb, tq, hi, carry, p0, p1); else sb_math<false>(st, kb, tq, hi, carry, p0, p1);
#pragma unroll
                for (int s = 0; s < 2; ++s) {
                    const unsigned char* vp0 = vb_ + qi * AT_VROW + (32 * sub + 16 * s + 4 * hi) * 2;
                    const unsigned char* vp1 = vp0 + 32 * AT_VROW;
                    const s16x4 a0 = *(const s16x4*)vp0, a1 = *(const s16x4*)(vp0 + 16), b0 = *(const s16x4*)vp1, b1 = *(const s16x4*)(vp1 + 16);
                    const bf16x8 v0 = (bf16x8){a0[0], a0[1], a0[2], a0[3], a1[0], a1[1], a1[2], a1[3]}, v1 = (bf16x8){b0[0], b0[1], b0[2], b0[3], b1[0], b1[1], b1[2], b1[3]};
                    o0 = __builtin_amdgcn_mfma_f32_32x32x16_bf16(v0, s ? p1 : p0, o0, 0, 0, 0);
                    o1 = __builtin_amdgcn_mfma_f32_32x32x16_bf16(v1, s ? p1 : p0, o1, 0, 0, 0);
                }
            }
            wdone = (__builtin_amdgcn_ballot_w64(carry != 0.f) == 0ull);
        }
        if (wdone && lane == 0) __hip_atomic_fetch_or(flg + (i & 1), 1u << w, __ATOMIC_RELAXED, __HIP_MEMORY_SCOPE_WORKGROUP);
    }
    bf16_t* op = C.PRE + qrow * DM + 512 + 64 * h + 4 * hi;
#pragma unroll
    for (int c = 0; c < 4; ++c) {
        *(u32x2*)(op + 8 * c) = (u32x2){cvt_pk_bf16(o0[4 * c], o0[4 * c + 1]), cvt_pk_bf16(o0[4 * c + 2], o0[4 * c + 3])};
        *(u32x2*)(op + 32 + 8 * c) = (u32x2){cvt_pk_bf16(o1[4 * c], o1[4 * c + 1]), cvt_pk_bf16(o1[4 * c + 2], o1[4 * c + 3])};
    }
    __syncthreads();
}

__device__ __forceinline__ void attn_skinny_unit(const Ctx& C, const float* k0, const float* v0, const float* k1, const float* v1, int S0, int S, int tq_base, size_t qrow_base, int h, unsigned char* shm) {
    const int tid = opaque_tid(), lane = tid & 63, qi = lane & 31, hi = lane >> 5, w = __builtin_amdgcn_readfirstlane(tid >> 6), q16 = qi & 15;
    const int tq = tq_base + q16;
    bf16x8 qf[4];
#pragma unroll
    for (int s = 0; s < 4; ++s) qf[s] = *(const bf16x8*)(C.Q + (qrow_base + q16) * 512 + 64 * h + 16 * s + 8 * hi);
    f32x16 o0, o1;
#pragma unroll
    for (int r = 0; r < 16; ++r) { o0[r] = 0.f; o1[r] = 0.f; }
    float carry = 1.f;
    const int nsb = (S + 31) >> 5, per = (nsb + 7) >> 3, sb_lo = w * per, sb_hi = min(nsb, sb_lo + per);
    for (int sb = sb_hi - 1; sb >= sb_lo; --sb) {
        const int kb = 32 * sb;
        const int key = min(kb + qi, S - 1);
        const float* kr = (key < S0 ? k0 + (size_t)key * 512 : k1 + (size_t)(key - S0) * 512) + 64 * h + 8 * hi;
        f32x16 st;
#pragma unroll
        for (int r = 0; r < 16; ++r) st[r] = 0.f;
#pragma unroll
        for (int s = 0; s < 4; ++s) {
            const f32x4 a = *(const f32x4*)(kr + 16 * s), bq = *(const f32x4*)(kr + 16 * s + 4);
            u32x4 pk; pk.x = cvt_pk_bf16(a[0], a[1]); pk.y = cvt_pk_bf16(a[2], a[3]); pk.z = cvt_pk_bf16(bq[0], bq[1]); pk.w = cvt_pk_bf16(bq[2], bq[3]);
            st = __builtin_amdgcn_mfma_f32_32x32x16_bf16(__builtin_bit_cast(bf16x8, pk), qf[s], st, 0, 0, 0);
        }
        bf16x8 p0, p1;
        sb_math<true>(st, kb, tq, hi, carry, p0, p1);
#pragma unroll
        for (int s = 0; s < 2; ++s) {
            float va[8], vb[8];
#pragma unroll
            for (int jj = 0; jj < 8; ++jj) {
                const int kk = min(kb + 16 * s + 4 * hi + (jj < 4 ? jj : jj + 4), S - 1);
                const float* vr = (kk < S0 ? v0 + (size_t)kk * 512 : v1 + (size_t)(kk - S0) * 512) + 64 * h + qi;
                va[jj] = vr[0]; vb[jj] = vr[32];
            }
            u32x4 pa, pb;
            pa.x = cvt_pk_bf16(va[0], va[1]); pa.y = cvt_pk_bf16(va[2], va[3]); pa.z = cvt_pk_bf16(va[4], va[5]); pa.w = cvt_pk_bf16(va[6], va[7]);
            pb.x = cvt_pk_bf16(vb[0], vb[1]); pb.y = cvt_pk_bf16(vb[2], vb[3]); pb.z = cvt_pk_bf16(vb[4], vb[5]); pb.w = cvt_pk_bf16(vb[6], vb[7]);
            o0 = __builtin_amdgcn_mfma_f32_32x32x16_bf16(__builtin_bit_cast(bf16x8, pa), s ? p1 : p0, o0, 0, 0, 0);
            o1 = __builtin_amdgcn_mfma_f32_32x32x16_bf16(__builtin_bit_cast(bf16x8, pb), s ? p1 : p0, o1, 0, 0, 0);
        }
    }
    float* OW = (float*)shm;
    float* RW = OW + 8 * 16 * 64;
    if (qi < 16) {
#pragma unroll
        for (int r = 0; r < 16; ++r) { OW[(w * 16 + qi) * 64 + crow(r, hi)] = o0[r]; OW[(w * 16 + qi) * 64 + 32 + crow(r, hi)] = o1[r]; }
        if (hi == 0) RW[w * 16 + qi] = carry;
    }
    __syncthreads();
    {
        const int q = tid >> 5, d = (tid & 31) * 2;
        float c = 1.f, a0 = 0.f, a1 = 0.f;
#pragma unroll
        for (int ww = 7; ww >= 0; --ww) { a0 += OW[(ww * 16 + q) * 64 + d] * c; a1 += OW[(ww * 16 + q) * 64 + d + 1] * c; c *= RW[ww * 16 + q]; }
        *(unsigned*)(C.PRE + (qrow_base + q) * DM + 512 + 64 * h + d) = cvt_pk_bf16(a0, a1);
    }
    __syncthreads();
}

template <int MODE>
__device__ __forceinline__ void poolconv_wave(const Ctx& C, int l, int ch, int g, int lane, float* PL) {
    constexpr bool samp = (MODE == 2);
    const int b = samp ? ch - 1028 : ch / 257, t0 = samp ? 0 : 16 * (ch % 257);
    const size_t rowbase = samp ? (size_t)NPR + 16 * b : (size_t)b * TP + t0;
    const int pos0 = samp ? 1024 : 0, c = 64 * g + lane, wnd = 2 << g;
    const float* spool = C.in[4] + ((size_t)l * 32 + b) * 15 * 256;
    const float* sconv = C.in[5] + ((size_t)l * 32 + b) * 2 * 256;
    float s[31], a[16];
#pragma unroll
    for (int r = 0; r < 31; ++r) {
        float v;
        if (MODE == 0) v = bf2f(C.PAB[(rowbase + (r - 15)) * DM + c]);
        else if (r >= 15) v = bf2f(C.PAB[(rowbase + (r - 15)) * DM + c]);
        else if (MODE == 2) v = spool[r * 256 + c];
        else v = 0.f;
        s[r] = v;
    }
#pragma unroll
    for (int i = 0; i < 16; ++i) a[i] = s[15 + i];
#pragma unroll
    for (int i = 30; i >= 1; --i) s[i] += s[i - 1];
    if (g >= 1) {
#pragma unroll
        for (int i = 30; i >= 3; --i) s[i] += s[i - 2];
    }
    if (g >= 2) {
#pragma unroll
        for (int i = 30; i >= 7; --i) s[i] += s[i - 4];
    }
    if (g >= 3) {
#pragma unroll
        for (int i = 30; i >= 15; --i) s[i] += s[i - 8];
    }
    float p[16], acc[16];
#pragma unroll
    for (int i = 0; i < 16; ++i) { const int pos = pos0 + t0 + i; p[i] = s[15 + i] / (float)min(pos + 1, wnd) - a[i]; acc[i] = 0.f; }
    const float* wp = C.in[13] + ((size_t)l * 4 + g) * 4096 + lane;
#pragma unroll
    for (int i = 0; i < 16; ++i) PL[i * 64 + lane] = p[i];
    asm volatile("s_waitcnt lgkmcnt(0)" ::: "memory");
#pragma unroll 2
    for (int k4 = 0; k4 < 16; ++k4) {
        const float w0 = wp[(4 * k4 + 0) * 64], w1 = wp[(4 * k4 + 1) * 64], w2 = wp[(4 * k4 + 2) * 64], w3 = wp[(4 * k4 + 3) * 64];
#pragma unroll
        for (int i = 0; i < 16; ++i) { const f32x4 pv = *(const f32x4*)(PL + i * 64 + 4 * k4); acc[i] += pv[0] * w0 + pv[1] * w1 + pv[2] * w2 + pv[3] * w3; }
    }
    asm volatile("s_waitcnt lgkmcnt(0)" ::: "memory");
    const float sc = C.in[14][l * 256 + c];
    const bool st_out = samp || t0 == 4096;
    float* pout = C.out + (samp ? OFF_PS + ((size_t)l * 32 + b) * 15 * 256 : OFF_PP + ((size_t)l * 4 + b) * 15 * 256) + c;
#pragma unroll
    for (int i = 0; i < 16; ++i) {
        C.PRE[(rowbase + i) * DM + c] = (bf16_t)(cvt_pk_bf16(acc[i] * sc, 0.f) & 0xffffu);
        if (st_out && i >= 1) pout[(i - 1) * 256] = a[i];
    }
    const float cw0 = C.in[16][(l * 3 + 0) * 256 + c], cw1 = C.in[16][(l * 3 + 1) * 256 + c], cw2 = C.in[16][(l * 3 + 2) * 256 + c];
    float e[18], gb[16];
#pragma unroll
    for (int i = 0; i < 18; ++i) {
        float v;
        if (MODE == 0 || i >= 2) { const bf16_t* r = C.PAB + (rowbase + (i - 2)) * DM; v = bf2f(r[768 + c]) * bf2f(r[256 + c]); }
        else if (MODE == 2) v = sconv[i * 256 + c];
        else v = 0.f;
        e[i] = v;
    }
#pragma unroll
    for (int i = 0; i < 16; ++i) gb[i] = bf2f(C.PAB[(rowbase + i) * DM + 512 + c]);
    float* cout = C.out + (samp ? OFF_CS + ((size_t)l * 32 + b) * 2 * 256 : OFF_CP + ((size_t)l * 4 + b) * 2 * 256) + c;
#pragma unroll
    for (int i = 0; i < 16; ++i) {
        const float y = gb[i] * (cw0 * e[i] + cw1 * e[i + 1] + cw2 * e[i + 2]);
        C.PRE[(rowbase + i) * DM + 256 + c] = (bf16_t)(cvt_pk_bf16(y, 0.f) & 0xffffu);
        if (st_out && i >= 14) cout[(i - 14) * 256] = e[i + 2];
    }
}

__device__ __forceinline__ void mixers_phase(const Ctx& C, int l, unsigned char* shm, int sub) {
    const int G = gridDim.x;
    if (sub & 1) for (int u = blockIdx.x; u < 256; u += G) {
        const int bh = (u & 7) * 4 + (u >> 6), jp = (u >> 3) & 7;
#ifndef NO_MAIN
        attn_main_unit(C, bh >> 3, bh & 7, 15 - jp, shm);
        attn_main_unit(C, bh >> 3, bh & 7, jp, shm);
#endif
    }
#ifndef NO_SKINNY
    if (sub & 2) for (int u = blockIdx.x; u < 288; u += G) {
        if (u < 256) {
            const int b = u >> 3, h = u & 7;
            attn_skinny_unit(C, C.in[2] + ((size_t)l * 32 + b) * 1024 * 512, C.in[3] + ((size_t)l * 32 + b) * 1024 * 512,
                             C.out + OFF_KS + ((size_t)l * NSR + 16 * b) * 512, C.out + OFF_VS + ((size_t)l * NSR + 16 * b) * 512, 1024, 1040, 1024, (size_t)NPR + 16 * b, h, shm);
        } else {
            const int b = (u - 256) >> 3, h = u & 7;
            const float* kp = C.out + OFF_KP + ((size_t)l * NPR + (size_t)b * TP) * 512; const float* vp = C.out + OFF_VP + ((size_t)l * NPR + (size_t)b * TP) * 512;
            attn_skinny_unit(C, kp, vp, kp, vp, 0, 16, 0, (size_t)b * TP, h, shm);
        }
    }
#endif
    if (sub & 4) {
        const int tid = opaque_tid(), lane = tid & 63, gw = blockIdx.x * 8 + __builtin_amdgcn_readfirstlane(tid >> 6), NGW = G * 8;
#ifndef NO_POOL
        for (int u = gw; u < 4240; u += NGW) {
            const int ch = u >> 2, g = u & 3; float* PL = (float*)shm + (tid >> 6) * 1024;
            if (ch >= 1028) poolconv_wave<2>(C, l, ch, g, lane, PL);
            else if (ch % 257 == 0) poolconv_wave<1>(C, l, ch, g, lane, PL);
            else poolconv_wave<0>(C, l, ch, g, lane, PL);
        }
#endif
    }
}

#define XB_TMO      128
#define XB_XCNT(j)  (256  + 64 * (j))
#define XB_XSUB(j)  (1280 + 64 * (j))
#define XB_XGEN(j)  (2304 + 64 * (j))
#define XB_TOP      3328
#define XB_TOPGEN   3392
#define XCD_BAR_WORDS 3456
#define XB_SPIN_CAP (1u << 18)
__device__ __forceinline__ unsigned xb_ld(unsigned* p)              { return __hip_atomic_load(p, __ATOMIC_RELAXED, __HIP_MEMORY_SCOPE_AGENT); }
__device__ __forceinline__ unsigned xb_add(unsigned* p, unsigned v) { return __hip_atomic_fetch_add(p, v, __ATOMIC_RELAXED, __HIP_MEMORY_SCOPE_AGENT); }
__device__ __forceinline__ unsigned xb_xcc_id() { return (unsigned)__builtin_amdgcn_s_getreg((3 << 11) | 20) & 0xFu; }
#define XB_SPIN(cond, bar) do { unsigned _sp = 0; while (cond) { __builtin_amdgcn_s_sleep(1); \
    if ((++_sp & 255u) == 0u) { if (xb_ld(&(bar)[XB_TMO])) break; if (_sp > XB_SPIN_CAP) { atomicAdd(&(bar)[XB_TMO], 1u); break; } } } } while (0)
struct XcdBarrier { unsigned* bar; unsigned x; volatile LAS unsigned* st; };
__device__ __forceinline__ XcdBarrier xcd_barrier_post(unsigned* bar, volatile LAS unsigned* st) {
    XcdBarrier b; b.bar = bar; b.x = xb_xcc_id(); b.st = st;
    if (threadIdx.x == 0) (void)xb_add(&bar[XB_XCNT(b.x)], 1u);
    return b;
}
__device__ __forceinline__ void xcd_barrier_complete(unsigned* bar, unsigned x, unsigned& nloc, unsigned& nx) {
    const unsigned G = gridDim.x * gridDim.y * gridDim.z;
    unsigned sum, cnt, mine, sp = 0u;
    for (;;) {
        sum = 0u; cnt = 0u; mine = 0u;
#pragma unroll
        for (unsigned j = 0; j < 16; ++j) { const unsigned c = xb_ld(&bar[XB_XCNT(j)]); sum += c; cnt += (c > 0u) ? 1u : 0u; mine = (j == x) ? c : mine; }
        if (sum == G) break;
        __builtin_amdgcn_s_sleep(1);
        if ((++sp & 255u) == 0u) { if (xb_ld(&bar[XB_TMO])) break; if (sp > XB_SPIN_CAP) { atomicAdd(&bar[XB_TMO], 1u); break; } }
    }
    nloc = mine > 0u ? mine : 1u; nx = cnt > 0u ? cnt : 1u;
}
__device__ __forceinline__ void xcd_barrier(const XcdBarrier& b) {
    asm volatile("s_waitcnt vmcnt(0)" ::: "memory");
    __syncthreads();
    if (threadIdx.x == 0) {
        unsigned* bar = b.bar;
        __builtin_amdgcn_s_waitcnt(0);
        unsigned nloc = b.st[0], nx = b.st[1];
        if (nloc == 0u) { xcd_barrier_complete(bar, b.x, nloc, nx); b.st[0] = nloc; b.st[1] = nx; }
        const unsigned old = xb_add(&bar[XB_XSUB(b.x)], 1u);
        const unsigned gen = old / nloc;
        if (old + 1u == (gen + 1u) * nloc) {
            __builtin_amdgcn_fence(__ATOMIC_RELEASE, "agent");
            asm volatile("s_waitcnt vmcnt(0)" ::: "memory");
            const unsigned og = xb_add(&bar[XB_TOP], 1u);
            const unsigned tg = og / nx;
            if (og + 1u == (tg + 1u) * nx) xb_add(&bar[XB_TOPGEN], 1u);
            else XB_SPIN(xb_ld(&bar[XB_TOPGEN]) == tg, bar);
            __builtin_amdgcn_fence(__ATOMIC_ACQUIRE, "agent");
            xb_add(&bar[XB_XGEN(b.x)], 1u);
            asm volatile("s_waitcnt vmcnt(0)" ::: "memory");
        } else {
            XB_SPIN(xb_ld(&bar[XB_XGEN(b.x)]) == gen, bar);
            __builtin_amdgcn_fence(__ATOMIC_ACQUIRE, "agent");
            asm volatile("s_waitcnt vmcnt(0)" ::: "memory");
        }
    }
    __syncthreads();
}

__global__ void __launch_bounds__(512, 2) mk_fwd(Args args) {
    extern __shared__ __attribute__((aligned(16))) unsigned char shm[];
    Ctx C;
    C.in = args.in; C.out = args.out; C.ws = args.ws;
    C.RSS = (float*)(args.ws + WS_RSS); C.XB = (bf16_t*)(args.ws + WS_XB); C.HF = (float*)(args.ws + WS_HF); C.ACT = (bf16_t*)(args.ws + WS_ACT); C.G = (bf16_t*)(args.ws + WS_G);
    C.PA = (float*)(args.ws + WS_PA); C.PAB = (bf16_t*)(args.ws + WS_PA); C.MIXF = (float*)(args.ws + WS_MIXF); C.MIXB = (bf16_t*)(args.ws + WS_MIXB); C.Q = (bf16_t*)(args.ws + WS_Q); C.KP = (bf16_t*)(args.ws + WS_KP) + 48 * 512; C.VT = (bf16_t*)(args.ws + WS_VT); C.VB = (bf16_t*)(args.ws + WS_VT) + 48 * 512; C.PRE = (bf16_t*)(args.ws + WS_PRE);
    volatile LAS unsigned* bst = (volatile LAS unsigned*)((LAS unsigned char*)shm + LDS_CTL);
    if (threadIdx.x < 4) bst[threadIdx.x] = 0u;
    __syncthreads();
    XcdBarrier bar; bar.bar = (unsigned*)(args.ws + WS_BAR); bar.x = 0; bar.st = bst;
    if (args.ph_hi - args.ph_lo > 1) bar = xcd_barrier_post((unsigned*)(args.ws + WS_BAR), bst);
    for (int ph = args.ph_lo; ph < args.ph_hi; ++ph) {
      for (int rep = 0; rep < ((ph == REP_PH) ? 2 : 1); ++rep) {
#ifndef NO_PRO
        if (ph == 0) prologue_phase(C, shm);
#else
        if (ph == 0) {}
#endif
        else {
            const int l = __builtin_amdgcn_readfirstlane((ph - 1) >> 3), s = __builtin_amdgcn_readfirstlane((ph - 1) & 7);
#ifndef NO_MIX
            if (s == 3) mixers_phase(C, l, shm, rep ? REP_SUB : 7);
#else
            if (s == 3) {}
#endif
            else {
                unsigned char* wl = args.ws + WS_W + (size_t)l * W_LAYER;
                pg8::Gemm g; pg8::Sched S; pg8::EpiDesc E;
                S.nM = MP / 256; S.G = gridDim.x; S.c = blockIdx.x; S.segs = 1;
                E.l = l; E.final_ = 0; E.alpha = 1.f; E.rss_in = C.RSS; E.rss_out = C.RSS;
                if (s == 0 || s == 6) { g.A = C.XB; g.lda = DM; g.Bt = (const bf16_t*)(wl + (s == 0 ? W_GU1 : W_GU2)); g.ldb = DM; S.nN = NIN / 256; S.nt_full = DM / 64; E.kind = pg8::EK_SWIGLU; E.rss_in = C.RSS + (size_t)(3 * l + (s == 0 ? 0 : 2)) * MP; }
                else if (s == 1 || s == 7) { g.A = C.ACT; g.lda = DFF; g.Bt = (const bf16_t*)(wl + (s == 1 ? W_DN1 : W_DN2)); g.ldb = DFF; S.nN = 4; S.nt_full = DFF / 64; E.kind = pg8::EK_RESID; E.alpha = 0.5f; E.rss_out = C.RSS + (size_t)(3 * l + (s == 1 ? 1 : 3)) * MP; E.final_ = (s == 7 && l == 1); }
                else if (s == 2) { g.A = C.XB; g.lda = DM; g.Bt = (const bf16_t*)(wl + W_IN); g.ldb = DM; S.nN = NIN / 256; S.nt_full = DM / 64; E.kind = pg8::EK_PROJ; E.rss_in = C.RSS + (size_t)(3 * l + 1) * MP; }
                else if (s == 4) { g.A = C.PRE; g.lda = DM; g.Bt = (const bf16_t*)(wl + W_BR); g.ldb = DM; S.nN = 4; S.nt_full = 0; S.segs = 3; E.kind = pg8::EK_BRANCH; }
                else { g.A = C.MIXB; g.lda = DM; g.Bt = (const bf16_t*)(wl + W_OUT); g.ldb = DM; S.nN = 4; S.nt_full = DM / 64; E.kind = pg8::EK_RESID; E.alpha = 1.f; E.rss_out = C.RSS + (size_t)(3 * l + 2) * MP; }
                if (S.nN == 4) S.nM = 64;
                S.nwg = S.nM * S.nN;
#ifndef NO_GEMM
                if (PERM_MASK == 0) pg8::gemm_phase<false>((LAS unsigned char*)shm, g, S, E, C);
                else if (PERM_MASK == 15) pg8::gemm_phase<true>((LAS unsigned char*)shm, g, S, E, C);
                else if ((PERM_MASK >> E.kind) & 1) pg8::gemm_phase<true>((LAS unsigned char*)shm, g, S, E, C);
                else pg8::gemm_phase<false>((LAS unsigned char*)shm, g, S, E, C);
                if (S.nN == 4) for (int su = blockIdx.x; su < 144; su += gridDim.x) pg8::small_unit(g, E, C, su, shm);
                if (S.nN == 4 && l == 0 && gridDim.x > 160 && blockIdx.x >= 144) {
                    const int part = (s == 1) ? 0 : (s == 4) ? 1 : (s == 5) ? 2 : 3;
                    const int lo = I_LAYER + (I_LAYER * part) / 4, hi = I_LAYER + (I_LAYER * (part + 1)) / 4;
                    convert_items(C, shm, lo, hi, (blockIdx.x - 144) * 8 + (threadIdx.x >> 6), (gridDim.x - 144) * 8);
                }
#endif
            }
        }
      }
        if (ph + 1 < args.ph_hi) { if (args.ph_hi > 1000) cg::this_grid().sync(); else xcd_barrier(bar); }
    }
}

extern "C" void kernel_launch(void* const* d_in, const int* in_sizes, int n_in, void* d_out, int out_size, void* d_ws, size_t ws_size, hipStream_t stream) {
    static int grid = 0;
    if (grid == 0) {
        if (n_in != 26 || (size_t)out_size != OUT_TOTAL || ws_size < WS_END) { fprintf(stderr, "kernel_launch: unexpected shapes: n_in %d out %d ws %zu (need %zu)\n", n_in, out_size, ws_size, (size_t)WS_END); grid = -1; return; }
        int dev = 0, cus = 0, per_cu = 0;
        hipGetDevice(&dev); hipDeviceGetAttribute(&cus, hipDeviceAttributeMultiprocessorCount, dev);
        if (hipFuncSetAttribute((const void*)mk_fwd, hipFuncAttributeMaxDynamicSharedMemorySize, LDS_BYTES) != hipSuccess) { fprintf(stderr, "kernel_launch: hipFuncSetAttribute failed\n"); grid = -1; return; }
        if (hipOccupancyMaxActiveBlocksPerMultiprocessor(&per_cu, (const void*)mk_fwd, 512, LDS_BYTES) != hipSuccess || per_cu < 1) { fprintf(stderr, "kernel_launch: occupancy query says %d\n", per_cu); per_cu = 1; }
        (void)hipGetLastError();
        grid = cus * per_cu;
    }
    if (grid < 0) return;
    Args a{};
    for (int i = 0; i < 26; ++i) a.in[i] = (const float*)d_in[i];
    a.out = (float*)d_out; a.ws = (unsigned char*)d_ws;
#if MK_ONE_LAUNCH
    if (hipMemsetAsync((unsigned char*)d_ws + WS_BAR, 0, XCD_BAR_WORDS * 4, stream) != hipSuccess) { fprintf(stderr, "memset failed\n"); return; }
    a.ph_lo = 0; a.ph_hi = 17;
    void* kargs[] = {&a};
    hipError_t e = hipLaunchCooperativeKernel((const void*)mk_fwd, dim3(grid), dim3(512), kargs, LDS_BYTES, stream);
    if (e != hipSuccess) fprintf(stderr, "cooperative launch failed: %s (grid %d)\n", hipGetErrorString(e), grid);
#else
    for (int ph = 0; ph < 17; ++ph) { a.ph_lo = ph; a.ph_hi = ph + 1; hipLaunchKernelGGL(mk_fwd, dim3(grid), dim3(512), LDS_BYTES, stream, a); }
#endif
}
```

```cpp
#include <hip/hip_runtime.h>
#include <hip/hip_cooperative_groups.h>
#include <cstdio>
#include <cstdint>
namespace cg = cooperative_groups;

#ifndef REP_PH
#define REP_PH -1
#endif
#ifndef REP_SUB
#define REP_SUB 7
#endif
#ifndef PERM_MASK
#define PERM_MASK 12
#endif
#ifndef MK_ONE_LAUNCH
#define MK_ONE_LAUNCH 1
#endif

#define LAS __attribute__((address_space(3)))
typedef unsigned short bf16_t;
typedef short bf16x8 __attribute__((ext_vector_type(8)));
typedef short s16x4 __attribute__((ext_vector_type(4)));
typedef float f32x4 __attribute__((ext_vector_type(4)));
typedef float f32x16 __attribute__((ext_vector_type(16)));
typedef unsigned u32x4 __attribute__((ext_vector_type(4)));
typedef unsigned u32x2 __attribute__((ext_vector_type(2)));

constexpr int DM = 1024, TP = 4112, NPR = 4 * TP, NSR = 512, MR = NPR + NSR, MP = 17152, DFF = 2816, NIN = 5632;
constexpr int LDV = 4160;
constexpr float RMS_EPS = 1e-6f;
constexpr float QSCALE = 0.125f * 1.4426950408889634f;
constexpr size_t OFF_YP = 0;
constexpr size_t OFF_YS = OFF_YP + (size_t)4 * 4096 * 1024;
constexpr size_t OFF_KP = OFF_YS + (size_t)512 * 1024;
constexpr size_t OFF_VP = OFF_KP + (size_t)2 * NPR * 512;
constexpr size_t OFF_PP = OFF_VP + (size_t)2 * NPR * 512;
constexpr size_t OFF_CP = OFF_PP + (size_t)2 * 4 * 15 * 256;
constexpr size_t OFF_KS = OFF_CP + (size_t)2 * 4 * 2 * 256;
constexpr size_t OFF_VS = OFF_KS + (size_t)2 * 512 * 512;
constexpr size_t OFF_PS = OFF_VS + (size_t)2 * 512 * 512;
constexpr size_t OFF_CS = OFF_PS + (size_t)2 * 32 * 15 * 256;
constexpr size_t OUT_TOTAL = OFF_CS + (size_t)2 * 32 * 2 * 256;
constexpr size_t MiB = 1u << 20;
constexpr size_t WS_RSS = 0;
constexpr size_t WS_BAR = 768 * 1024;
constexpr size_t WS_W = 1 * MiB;
constexpr size_t W_GU1 = 0, W_DN1 = W_GU1 + (size_t)NIN * DM * 2, W_IN = W_DN1 + (size_t)DM * DFF * 2, W_BR = W_IN + (size_t)NIN * DM * 2,
                 W_OUT = W_BR + (size_t)DM * DM * 2, W_GU2 = W_OUT + (size_t)DM * DM * 2, W_DN2 = W_GU2 + (size_t)NIN * DM * 2, W_LAYER = W_DN2 + (size_t)DM * DFF * 2;
static_assert(W_LAYER == 48 * MiB, "weights per layer");
constexpr size_t WS_XB = 97 * MiB;
constexpr size_t WS_HF = 131 * MiB;
constexpr size_t WS_ACT = 198 * MiB;
constexpr size_t WS_G = 198 * MiB;
constexpr size_t WS_PA = 299 * MiB;
constexpr size_t WS_MIXF = 299 * MiB;
constexpr size_t WS_MIXB = 366 * MiB;
constexpr size_t WS_Q = 366 * MiB;
constexpr size_t WS_KP = 383 * MiB;
constexpr size_t WS_VT = 400 * MiB;
constexpr size_t WS_PRE = 421 * MiB;
constexpr size_t WS_END = 455 * MiB;
static_assert(WS_XB + (size_t)MP * DM * 2 <= WS_HF && WS_HF + (size_t)MP * DM * 4 <= WS_ACT && WS_G + (size_t)MP * 3072 * 2 <= WS_PA && WS_PA + (size_t)MP * DM * 4 <= WS_Q &&
              WS_Q + (size_t)MP * 512 * 2 <= WS_KP && WS_KP + (size_t)(48 + MP) * 1024 <= WS_VT && WS_VT + (size_t)40 * 64 * LDV * 2 <= WS_PRE && WS_PRE + (size_t)MP * DM * 2 <= WS_END, "ws map");
constexpr int LDS_CTL = 8 * 16640;
constexpr int LDS_BYTES = LDS_CTL + 64;

struct Args { const float* in[26]; float* out; unsigned char* ws; int ph_lo, ph_hi; };

struct Ctx {
    const float* const* in;
    float* out; unsigned char* ws;
    float* RSS; bf16_t* XB; float* HF; bf16_t* ACT; bf16_t* G; float* PA; float* MIXF; bf16_t* PAB; bf16_t* MIXB; bf16_t* Q; bf16_t* KP; bf16_t* VT; bf16_t* VB; bf16_t* PRE;
};

__device__ __forceinline__ unsigned cvt_pk_bf16(float lo, float hi) { unsigned r; asm volatile("v_cvt_pk_bf16_f32 %0, %1, %2" : "=v"(r) : "v"(lo), "v"(hi)); return r; }
__device__ __forceinline__ u32x2 pk4(f32x4 v) { u32x2 r; r.x = cvt_pk_bf16(v[0], v[1]); r.y = cvt_pk_bf16(v[2], v[3]); return r; }
__device__ __forceinline__ float bf2f(unsigned short b) { return __uint_as_float(((unsigned)b) << 16); }
__device__ __forceinline__ f32x4 unpk4(u32x2 p) { f32x4 r; r[0] = __uint_as_float(p.x << 16); r[1] = __uint_as_float(p.x & 0xffff0000u); r[2] = __uint_as_float(p.y << 16); r[3] = __uint_as_float(p.y & 0xffff0000u); return r; }
__device__ __forceinline__ int opaque_tid() { int t = threadIdx.x; asm volatile("" : "+v"(t)); return t; }
__device__ __forceinline__ int opaque_bid() { int t = blockIdx.x; asm volatile("" : "+s"(t)); return t; }
__device__ __forceinline__ int crow(int r, int hi) { return (r & 3) + 8 * (r >> 2) + 4 * hi; }

namespace pg8 {
constexpr int BM = 256, BK = 64, HALF = 128, HTB = HALF * BK * 2, STAGE_BYTES = 8 * HTB, NXCD = 8, WGM = 8;
__host__ __device__ __forceinline__ int lds_byte(int r, int c) { const int st = (r >> 4) * 2 + (c >> 5), rr = r & 15, cc = c & 31, ob = rr * 64 + cc * 2; return st * 1024 + (ob ^ (((ob >> 9) & 1) << 5)); }
__host__ __device__ __forceinline__ void stage_rc(int b, int& R, int& C) { const int st = b / 1024, sb = b % 1024, swz = sb ^ (((sb >> 9) & 1) << 5); R = (st >> 1) * 16 + swz / 64; C = (st & 1) * 32 + (swz % 64) / 2; }

struct Unit { int pm, pn, kofs, nt, seg; };
struct Gemm { const bf16_t* A; const bf16_t* Bt; int lda, ldb; };
struct Sched {
    int nM, nN, nwg, G, c, segs, nt_full;
    __device__ bool next(int i, Unit& u) const {
        const int ti = (segs == 3) ? i / 3 : i; const int sg = (segs == 3) ? i - 3 * ti : 3;
        const long L = (long)ti * G + c; if (L >= nwg) return false;
        int wgid = (int)L; { const int q = nwg / NXCD, r = nwg % NXCD, xcd = wgid % NXCD, off = wgid / NXCD; wgid = (xcd < r ? xcd * (q + 1) : r * (q + 1) + (xcd - r) * q) + off; }
        const int nig = WGM * nN, gid = wgid / nig, fm = gid * WGM, gsz = (nM - fm) < WGM ? (nM - fm) : WGM;
        u.pm = fm + ((wgid % nig) % gsz); u.pn = (wgid % nig) / gsz;
        u.seg = sg;
        if (segs == 3) { u.kofs = sg == 0 ? 0 : (sg == 1 ? 256 : 512); u.nt = sg == 2 ? 8 : 4; }
        else { u.kofs = 0; u.nt = nt_full; }
        return true;
    }
};
enum { EK_SWIGLU = 0, EK_RESID = 1, EK_PROJ = 2, EK_BRANCH = 3 };
struct EpiDesc { int kind, l, final_; float alpha; const float* rss_in; float* rss_out; };

__device__ __forceinline__ float sigmoidf_(float v) { return __builtin_amdgcn_rcpf(1.f + __builtin_amdgcn_exp2f(-1.4426950408889634f * v)); }

template <int K>
__device__ __forceinline__ void epilogue(const f32x4 (&acc)[2][2][4][2], const Unit& u, const EpiDesc& E, const Ctx& C, int wr, int wc, int fr, int fq) {
    const int row0 = u.pm * 256 + wr * 64 + fr;
    const int lc0 = 32 * wc + 4 * fq;
    if (K == EK_SWIGLU || K == EK_PROJ) {
        float rstd[2][4];
#pragma unroll
        for (int ai = 0; ai < 2; ++ai)
#pragma unroll
            for (int m = 0; m < 4; ++m) rstd[ai][m] = E.rss_in[row0 + 128 * ai + 16 * m];
#pragma unroll
        for (int ai = 0; ai < 2; ++ai)
#pragma unroll
            for (int m = 0; m < 4; ++m) rstd[ai][m] = __builtin_amdgcn_rsqf(rstd[ai][m] * (1.f / 1024.f) + RMS_EPS);
        if (K == EK_SWIGLU) {
#pragma unroll
            for (int ai = 0; ai < 2; ++ai)
#pragma unroll
                for (int m = 0; m < 4; ++m) {
                    const int row = row0 + 128 * ai + 16 * m;
#pragma unroll
                    for (int bj = 0; bj < 2; ++bj) {
                        const f32x4 g = acc[ai][bj][m][0] * rstd[ai][m], up = acc[ai][bj][m][1] * rstd[ai][m];
                        f32x4 a;
#pragma unroll
                        for (int i = 0; i < 4; ++i) a[i] = g[i] * sigmoidf_(g[i]) * up[i];
                        const int j = 16 * (8 * u.pn + 4 * bj + wc) + 4 * fq;
                        *(u32x2*)(C.ACT + (size_t)row * DFF + j) = pk4(a);
                    }
                }
        } else {
            const int pn = u.pn, l = E.l;
            if (pn < 4) {
#pragma unroll
                for (int ai = 0; ai < 2; ++ai)
#pragma unroll
                    for (int m = 0; m < 4; ++m) {
                        const int row = row0 + 128 * ai + 16 * m;
#pragma unroll
                        for (int bj = 0; bj < 2; ++bj)
#pragma unroll
                            for (int n = 0; n < 2; ++n) *(u32x2*)(C.PAB + (size_t)row * DM + 256 * pn + 128 * bj + 16 * n + lc0) = pk4(acc[ai][bj][m][n] * rstd[ai][m]);
                    }
            } else if (pn < 8) {
                const bool isk = pn >= 6; const int head = 4 * (pn & 1) + wc;
                const float* gn = C.in[isk ? 19 : 18] + (size_t)l * 512 + 64 * head + 4 * fq;
                f32x4 gv[2][2];
#pragma unroll
                for (int bj = 0; bj < 2; ++bj)
#pragma unroll
                    for (int n = 0; n < 2; ++n) gv[bj][n] = *(const f32x4*)(gn + 32 * bj + 16 * n) * (isk ? 1.f : QSCALE);
#pragma unroll
                for (int ai = 0; ai < 2; ++ai)
#pragma unroll
                    for (int m = 0; m < 4; ++m) {
                        const int row = row0 + 128 * ai + 16 * m;
                        f32x4 v[2][2]; float ss = 0.f;
#pragma unroll
                        for (int bj = 0; bj < 2; ++bj)
#pragma unroll
                            for (int n = 0; n < 2; ++n) { v[bj][n] = acc[ai][bj][m][n] * rstd[ai][m]; ss += v[bj][n][0] * v[bj][n][0] + v[bj][n][1] * v[bj][n][1] + v[bj][n][2] * v[bj][n][2] + v[bj][n][3] * v[bj][n][3]; }
                        ss += __shfl_xor(ss, 16); ss += __shfl_xor(ss, 32);
                        const float rinv = __builtin_amdgcn_rsqf(ss * (1.f / 64.f) + RMS_EPS);
                        float* kdst = (float*)(C.PRE + (size_t)row * DM);
                        if (row < NPR) kdst = C.out + OFF_KP + ((size_t)l * NPR + row) * 512; else if (row < MR) kdst = C.out + OFF_KS + ((size_t)l * NSR + (row - NPR)) * 512;
                        bf16_t* bdst = (isk ? C.KP : C.Q) + (size_t)row * 512 + 64 * head + 4 * fq;
#pragma unroll
                        for (int bj = 0; bj < 2; ++bj)
#pragma unroll
                            for (int n = 0; n < 2; ++n) {
                                const int d = 32 * bj + 16 * n;
                                const f32x4 o = v[bj][n] * rinv * gv[bj][n];
                                *(u32x2*)(bdst + d) = pk4(o);
                                if (isk) *(f32x4*)(kdst + 64 * head + 4 * fq + d) = o;
                            }
                    }
            } else if (pn < 10) {
#pragma unroll
                for (int ai = 0; ai < 2; ++ai)
#pragma unroll
                    for (int m = 0; m < 4; ++m) {
                        const int row = row0 + 128 * ai + 16 * m;
                        float* vdst = (float*)(C.PRE + (size_t)row * DM);
                        if (row < NPR) vdst = C.out + OFF_VP + ((size_t)l * NPR + row) * 512; else if (row < MR) vdst = C.out + OFF_VS + ((size_t)l * NSR + (row - NPR)) * 512;
#pragma unroll
                        for (int bj = 0; bj < 2; ++bj)
#pragma unroll
                            for (int n = 0; n < 2; ++n) {
                                const int c512 = 256 * (pn - 8) + 128 * bj + 16 * n + lc0;
                                const f32x4 o = acc[ai][bj][m][n] * rstd[ai][m];
                                *(f32x4*)(vdst + c512) = o;
                                *(u32x2*)(C.VB + (size_t)row * 512 + c512) = pk4(o);
                            }
                    }
            } else {
                const int br = (pn - 10) >> 2, cb = 256 * ((pn - 10) & 3);
#pragma unroll
                for (int ai = 0; ai < 2; ++ai)
#pragma unroll
                    for (int m = 0; m < 4; ++m) {
                        const int row = row0 + 128 * ai + 16 * m;
#pragma unroll
                        for (int bj = 0; bj < 2; ++bj)
#pragma unroll
                            for (int n = 0; n < 2; ++n) {
                                const f32x4 x = acc[ai][bj][m][n] * rstd[ai][m]; f32x4 sg;
#pragma unroll
                                for (int i = 0; i < 4; ++i) sg[i] = fmaxf(sigmoidf_(x[i]), 1e-30f);
                                *(u32x2*)(C.G + (size_t)row * 3072 + br * 1024 + cb + 128 * bj + 16 * n + lc0) = pk4(sg);
                            }
                    }
            }
        }
    } else if (K == EK_RESID) {
#pragma unroll
        for (int ai = 0; ai < 2; ++ai)
#pragma unroll
        for (int mh = 0; mh < 2; ++mh) {
            u32x2 h[2][2][2];
#pragma unroll
            for (int m2 = 0; m2 < 2; ++m2)
#pragma unroll
                for (int bj = 0; bj < 2; ++bj)
#pragma unroll
                    for (int n = 0; n < 2; ++n) h[m2][bj][n] = *(const u32x2*)(C.XB + (size_t)(row0 + 128 * ai + 16 * (2 * mh + m2)) * DM + 256 * u.pn + 128 * bj + 16 * n + lc0);
#pragma unroll
            for (int m2 = 0; m2 < 2; ++m2) {
                const int m = 2 * mh + m2;
                const int row = row0 + 128 * ai + 16 * m;
                float* dst = C.PA + (size_t)row * DM;
                if (E.final_) {
                    if (row < NPR) { const int b = row / TP, t = row - b * TP; if (t >= 16) dst = C.out + OFF_YP + ((size_t)b * 4096 + (t - 16)) * 1024; }
                    else if (row < MR) dst = C.out + OFF_YS + (size_t)(row - NPR) * 1024;
                }
                float ss = 0.f;
#pragma unroll
                for (int bj = 0; bj < 2; ++bj)
#pragma unroll
                    for (int n = 0; n < 2; ++n) {
                        const int col = 256 * u.pn + 128 * bj + 16 * n + lc0;
                        const f32x4 hv = unpk4(h[m2][bj][n]) + acc[ai][bj][m][n] * E.alpha;
                        if (E.final_) *(f32x4*)(dst + col) = hv;
                        else {
                            *(u32x2*)(C.XB + (size_t)row * DM + col) = pk4(hv);
                            ss += hv[0] * hv[0] + hv[1] * hv[1] + hv[2] * hv[2] + hv[3] * hv[3];
                        }
                    }
                if (!E.final_) {
                    ss += __shfl_xor(ss, 16); ss += __shfl_xor(ss, 32);
                    if (fq == 0) unsafeAtomicAdd(E.rss_out + row, ss);
                }
            }
        }
    } else {
        const int seg = u.seg;
#pragma unroll
        for (int ai = 0; ai < 2; ++ai)
#pragma unroll
        for (int mh = 0; mh < 2; ++mh) {
            u32x2 gq[2][2][2], mf[2][2][2];
#pragma unroll
            for (int m2 = 0; m2 < 2; ++m2)
#pragma unroll
                for (int bj = 0; bj < 2; ++bj)
#pragma unroll
                    for (int n = 0; n < 2; ++n) {
                        const int row = row0 + 128 * ai + 16 * (2 * mh + m2), col = 256 * u.pn + 128 * bj + 16 * n + lc0;
                        gq[m2][bj][n] = *(const u32x2*)(C.G + (size_t)row * 3072 + seg * 1024 + col);
                        if (seg > 0) mf[m2][bj][n] = *(const u32x2*)(C.MIXB + (size_t)row * DM + col); else mf[m2][bj][n] = (u32x2){0u, 0u};
                    }
#pragma unroll
            for (int m2 = 0; m2 < 2; ++m2)
#pragma unroll
                for (int bj = 0; bj < 2; ++bj)
#pragma unroll
                    for (int n = 0; n < 2; ++n) {
                        const int row = row0 + 128 * ai + 16 * (2 * mh + m2), col = 256 * u.pn + 128 * bj + 16 * n + lc0;
                        const f32x4 r = acc[ai][bj][2 * mh + m2][n] * unpk4(gq[m2][bj][n]) + unpk4(mf[m2][bj][n]);
                        *(u32x2*)(C.MIXB + (size_t)row * DM + col) = pk4(r);
                    }
        }
    }
}

__host__ __device__ __forceinline__ int perm32(int rho) { const int n = rho >> 4, i = rho & 15; return 8 * (i >> 2) + 4 * n + (i & 3); }
__device__ __forceinline__ u32x4 pk8(f32x4 a, f32x4 b) { const u32x2 p = pk4(a), q = pk4(b); return (u32x4){p.x, p.y, q.x, q.y}; }
template <int K>
__device__ __forceinline__ void epilogue_p(const f32x4 (&acc)[2][2][4][2], const Unit& u, const EpiDesc& E, const Ctx& C, int wr, int wc, int fr, int fq) {
    const int row0 = u.pm * 256 + wr * 64 + fr;
    const int lc8 = 32 * wc + 8 * fq;
    if (K == EK_SWIGLU || K == EK_PROJ) {
        float rstd[2][4];
#pragma unroll
        for (int ai = 0; ai < 2; ++ai)
#pragma unroll
            for (int m = 0; m < 4; ++m) rstd[ai][m] = E.rss_in[row0 + 128 * ai + 16 * m];
#pragma unroll
        for (int ai = 0; ai < 2; ++ai)
#pragma unroll
            for (int m = 0; m < 4; ++m) rstd[ai][m] = __builtin_amdgcn_rsqf(rstd[ai][m] * (1.f / 1024.f) + RMS_EPS);
        if (K == EK_SWIGLU) {
#pragma unroll
            for (int ai = 0; ai < 2; ++ai)
#pragma unroll
                for (int m = 0; m < 4; ++m) {
                    const int row = row0 + 128 * ai + 16 * m;
                    f32x4 a[2];
#pragma unroll
                    for (int n = 0; n < 2; ++n) {
                        const f32x4 g = acc[ai][0][m][n] * rstd[ai][m], up = acc[ai][1][m][n] * rstd[ai][m];
#pragma unroll
                        for (int i = 0; i < 4; ++i) a[n][i] = g[i] * sigmoidf_(g[i]) * up[i];
                    }
                    *(u32x4*)(C.ACT + (size_t)row * DFF + 128 * u.pn + lc8) = pk8(a[0], a[1]);
                }
        } else {
            const int pn = u.pn, l = E.l;
            if (pn < 4) {
#pragma unroll
                for (int ai = 0; ai < 2; ++ai)
#pragma unroll
                    for (int m = 0; m < 4; ++m) {
                        const int row = row0 + 128 * ai + 16 * m;
#pragma unroll
                        for (int bj = 0; bj < 2; ++bj) *(u32x4*)(C.PAB + (size_t)row * DM + 256 * pn + 128 * bj + lc8) = pk8(acc[ai][bj][m][0] * rstd[ai][m], acc[ai][bj][m][1] * rstd[ai][m]);
                    }
            } else if (pn < 8) {
                const bool isk = pn >= 6; const int head = 4 * (pn & 1) + wc;
                const float* gn = C.in[isk ? 19 : 18] + (size_t)l * 512 + 64 * head + 8 * fq;
                f32x4 gv[2][2];
#pragma unroll
                for (int bj = 0; bj < 2; ++bj)
#pragma unroll
                    for (int n = 0; n < 2; ++n) gv[bj][n] = *(const f32x4*)(gn + 32 * bj + 4 * n) * (isk ? 1.f : QSCALE);
#pragma unroll
                for (int ai = 0; ai < 2; ++ai)
#pragma unroll
                    for (int m = 0; m < 4; ++m) {
                        const int row = row0 + 128 * ai + 16 * m;
                        f32x4 v[2][2]; float ss = 0.f;
#pragma unroll
                        for (int bj = 0; bj < 2; ++bj)
#pragma unroll
                            for (int n = 0; n < 2; ++n) { v[bj][n] = acc[ai][bj][m][n] * rstd[ai][m]; ss += v[bj][n][0] * v[bj][n][0] + v[bj][n][1] * v[bj][n][1] + v[bj][n][2] * v[bj][n][2] + v[bj][n][3] * v[bj][n][3]; }
                        ss += __shfl_xor(ss, 16); ss += __shfl_xor(ss, 32);
                        const float rinv = __builtin_amdgcn_rsqf(ss * (1.f / 64.f) + RMS_EPS);
                        float* kdst = (float*)(C.PRE + (size_t)row * DM);
                        if (row < NPR) kdst = C.out + OFF_KP + ((size_t)l * NPR + row) * 512; else if (row < MR) kdst = C.out + OFF_KS + ((size_t)l * NSR + (row - NPR)) * 512;
                        bf16_t* bdst = (isk ? C.KP : C.Q) + (size_t)row * 512 + 64 * head + 8 * fq;
#pragma unroll
                        for (int bj = 0; bj < 2; ++bj) {
                            const f32x4 o0 = v[bj][0] * rinv * gv[bj][0], o1 = v[bj][1] * rinv * gv[bj][1];
                            *(u32x4*)(bdst + 32 * bj) = pk8(o0, o1);
                            if (isk) { *(f32x4*)(kdst + 64 * head + 8 * fq + 32 * bj) = o0; *(f32x4*)(kdst + 64 * head + 8 * fq + 32 * bj + 4) = o1; }
                        }
                    }
            } else if (pn < 10) {
#pragma unroll
                for (int ai = 0; ai < 2; ++ai)
#pragma unroll
                    for (int m = 0; m < 4; ++m) {
                        const int row = row0 + 128 * ai + 16 * m;
                        float* vdst = (float*)(C.PRE + (size_t)row * DM);
                        if (row < NPR) vdst = C.out + OFF_VP + ((size_t)l * NPR + row) * 512; else if (row < MR) vdst = C.out + OFF_VS + ((size_t)l * NSR + (row - NPR)) * 512;
#pragma unroll
                        for (int bj = 0; bj < 2; ++bj) {
                            const int c512 = 256 * (pn - 8) + 128 * bj + lc8;
                            const f32x4 o0 = acc[ai][bj][m][0] * rstd[ai][m], o1 = acc[ai][bj][m][1] * rstd[ai][m];
                            *(f32x4*)(vdst + c512) = o0; *(f32x4*)(vdst + c512 + 4) = o1;
                            *(u32x4*)(C.VB + (size_t)row * 512 + c512) = pk8(o0, o1);
                        }
                    }
            } else {
                const int br = (pn - 10) >> 2, cb = 256 * ((pn - 10) & 3);
#pragma unroll
                for (int ai = 0; ai < 2; ++ai)
#pragma unroll
                    for (int m = 0; m < 4; ++m) {
                        const int row = row0 + 128 * ai + 16 * m;
#pragma unroll
                        for (int bj = 0; bj < 2; ++bj) {
                            f32x4 sg[2];
#pragma unroll
                            for (int n = 0; n < 2; ++n) {
                                const f32x4 x = acc[ai][bj][m][n] * rstd[ai][m];
#pragma unroll
                                for (int i = 0; i < 4; ++i) sg[n][i] = fmaxf(sigmoidf_(x[i]), 1e-30f);
                            }
                            *(u32x4*)(C.G + (size_t)row * 3072 + br * 1024 + cb + 128 * bj + lc8) = pk8(sg[0], sg[1]);
                        }
                    }
            }
        }
    } else if (K == EK_RESID) {
#pragma unroll
        for (int ai = 0; ai < 2; ++ai)
#pragma unroll
        for (int mh = 0; mh < 2; ++mh) {
            u32x4 h[2][2];
#pragma unroll
            for (int m2 = 0; m2 < 2; ++m2)
#pragma unroll
                for (int bj = 0; bj < 2; ++bj) h[m2][bj] = *(const u32x4*)(C.XB + (size_t)(row0 + 128 * ai + 16 * (2 * mh + m2)) * DM + 256 * u.pn + 128 * bj + lc8);
#pragma unroll
            for (int m2 = 0; m2 < 2; ++m2) {
                const int m = 2 * mh + m2;
                const int row = row0 + 128 * ai + 16 * m;
                float* dst = C.PA + (size_t)row * DM;
                if (E.final_) {
                    if (row < NPR) { const int b = row / TP, t = row - b * TP; if (t >= 16) dst = C.out + OFF_YP + ((size_t)b * 4096 + (t - 16)) * 1024; }
                    else if (row < MR) dst = C.out + OFF_YS + (size_t)(row - NPR) * 1024;
                }
                float ss = 0.f;
#pragma unroll
                for (int bj = 0; bj < 2; ++bj) {
                    const int col = 256 * u.pn + 128 * bj + lc8;
                    const f32x4 hv0 = unpk4((u32x2){h[m2][bj].x, h[m2][bj].y}) + acc[ai][bj][m][0] * E.alpha, hv1 = unpk4((u32x2){h[m2][bj].z, h[m2][bj].w}) + acc[ai][bj][m][1] * E.alpha;
                    if (E.final_) { *(f32x4*)(dst + col) = hv0; *(f32x4*)(dst + col + 4) = hv1; }
                    else {
                        *(u32x4*)(C.XB + (size_t)row * DM + col) = pk8(hv0, hv1);
                        ss += hv0[0] * hv0[0] + hv0[1] * hv0[1] + hv0[2] * hv0[2] + hv0[3] * hv0[3] + hv1[0] * hv1[0] + hv1[1] * hv1[1] + hv1[2] * hv1[2] + hv1[3] * hv1[3];
                    }
                }
                if (!E.final_) {
                    ss += __shfl_xor(ss, 16); ss += __shfl_xor(ss, 32);
                    if (fq == 0) unsafeAtomicAdd(E.rss_out + row, ss);
                }
            }
        }
    } else {
        const int seg = u.seg;
#pragma unroll
        for (int ai = 0; ai < 2; ++ai)
#pragma unroll
        for (int mh = 0; mh < 2; ++mh) {
            u32x4 gq[2][2], mf[2][2];
#pragma unroll
            for (int m2 = 0; m2 < 2; ++m2)
#pragma unroll
                for (int bj = 0; bj < 2; ++bj) {
                    const int row = row0 + 128 * ai + 16 * (2 * mh + m2), col = 256 * u.pn + 128 * bj + lc8;
                    gq[m2][bj] = *(const u32x4*)(C.G + (size_t)row * 3072 + seg * 1024 + col);
                    if (seg > 0) mf[m2][bj] = *(const u32x4*)(C.MIXB + (size_t)row * DM + col); else mf[m2][bj] = (u32x4){0u, 0u, 0u, 0u};
                }
#pragma unroll
            for (int m2 = 0; m2 < 2; ++m2)
#pragma unroll
                for (int bj = 0; bj < 2; ++bj) {
                    const int m = 2 * mh + m2;
                    const int row = row0 + 128 * ai + 16 * m, col = 256 * u.pn + 128 * bj + lc8;
                    const f32x4 r0 = acc[ai][bj][m][0] * unpk4((u32x2){gq[m2][bj].x, gq[m2][bj].y}) + unpk4((u32x2){mf[m2][bj].x, mf[m2][bj].y});
                    const f32x4 r1 = acc[ai][bj][m][1] * unpk4((u32x2){gq[m2][bj].z, gq[m2][bj].w}) + unpk4((u32x2){mf[m2][bj].z, mf[m2][bj].w});
                    *(u32x4*)(C.MIXB + (size_t)row * DM + col) = pk8(r0, r1);
                }
        }
    }
}

template <bool PERM>
__device__ __forceinline__ void gemm_phase(LAS unsigned char* lds, const Gemm g, const Sched& S, const EpiDesc& E, const Ctx& C) {
    const int tid = opaque_tid(), wid = __builtin_amdgcn_readfirstlane(tid >> 6), lane = tid & 63, wr = wid >> 2, wc = wid & 3, fr = lane & 15, fq = lane >> 4;
    unsigned voffA[2], voffB[2];
#pragma unroll
    for (int i = 0; i < 2; ++i) { int R, Cc; stage_rc(tid * 16 + i * 8192, R, Cc); const int Rb = PERM ? (R & ~31) + perm32(R & 31) : R; voffA[i] = (unsigned)(R * g.lda + Cc) * 2u; voffB[i] = (unsigned)(Rb * g.ldb + Cc) * 2u; }
    const size_t kstep = (size_t)(BK * 2);
    const size_t hstepA = (size_t)HALF * g.lda * 2, hstepB = (size_t)HALF * g.ldb * 2;
    const size_t tstepA = 2 * hstepA, tstepB = 2 * hstepB;
    const unsigned ldsw = (unsigned)wid * 1024u;
    const int aoff = lds_byte(wr * 64 + fr, fq * 8), boff = lds_byte(wc * 32 + fr, fq * 8);
#define PG8_SA(b, h) (((b) * 2 + (h)) * HTB)
#define PG8_SB(b, h) ((4 + (b) * 2 + (h)) * HTB)
#define PG8_STAGE(bufoff, gbase, voff) do { _Pragma("unroll") for (int _i = 0; _i < 2; ++_i) \
        __builtin_amdgcn_global_load_lds((const unsigned*)((const char*)(gbase) + (voff)[_i]), (LAS unsigned*)(lds + (bufoff) + ldsw + _i * 8192), 16, 0, 0); } while (0)
#define PG8_LDA(dst, b, h) do { _Pragma("unroll") for (int m = 0; m < 4; ++m) _Pragma("unroll") for (int k = 0; k < 2; ++k) dst[m][k] = *(const LAS bf16x8*)(lds + PG8_SA(b, h) + aoff + m * 2048 + k * 1024); } while (0)
#define PG8_LDB(dst, b, h) do { _Pragma("unroll") for (int n = 0; n < 2; ++n) _Pragma("unroll") for (int k = 0; k < 2; ++k) dst[n][k] = *(const LAS bf16x8*)(lds + PG8_SB(b, h) + boff + n * 2048 + k * 1024); } while (0)
#define PG8_MMA(ai, bj, At, Bt) do { __builtin_amdgcn_s_setprio(1); _Pragma("unroll") for (int m = 0; m < 4; ++m) _Pragma("unroll") for (int n = 0; n < 2; ++n) _Pragma("unroll") for (int k = 0; k < 2; ++k) \
        acc[ai][bj][m][n] = __builtin_amdgcn_mfma_f32_16x16x32_bf16(Bt[n][k], At[m][k], acc[ai][bj][m][n], 0, 0, 0); __builtin_amdgcn_s_setprio(0); } while (0)
#define PG8_WAIT_V(n) asm volatile("s_waitcnt vmcnt(" #n ")" ::: "memory")
#define PG8_WAIT_L(n) asm volatile("s_waitcnt lgkmcnt(" #n ")" ::: "memory")
#define PG8_BAR __builtin_amdgcn_s_barrier()
#define PG8_SCHED __builtin_amdgcn_sched_barrier(0)
    Unit cur, nxt; int ui = 0;
    if (!S.next(0, cur)) return;
    f32x4 acc[2][2][4][2];
#pragma unroll
    for (int a = 0; a < 2; ++a)
#pragma unroll
        for (int b = 0; b < 2; ++b)
#pragma unroll
            for (int m = 0; m < 4; ++m)
#pragma unroll
                for (int n = 0; n < 2; ++n) acc[a][b][m][n] = (f32x4){0.f, 0.f, 0.f, 0.f};
    bf16x8 At[4][2], B0[2][2], B1[2][2];
    const char* cA = (const char*)g.A + (size_t)cur.pm * tstepA + (size_t)cur.kofs * 2; const char* cB = (const char*)g.Bt + (size_t)cur.pn * tstepB + (size_t)cur.kofs * 2;
    PG8_STAGE(PG8_SB(0, 0), cB, voffB); PG8_STAGE(PG8_SB(0, 1), cB + hstepB, voffB); PG8_STAGE(PG8_SA(0, 0), cA, voffA); PG8_STAGE(PG8_SA(0, 1), cA + hstepA, voffA);
    if (wr == 1) PG8_BAR;
    PG8_WAIT_V(2); PG8_BAR;
    PG8_STAGE(PG8_SB(1, 0), cB + kstep, voffB); PG8_STAGE(PG8_SA(1, 0), cA + kstep, voffA); PG8_STAGE(PG8_SB(1, 1), cB + hstepB + kstep, voffB);
    PG8_WAIT_V(6); PG8_BAR;
    for (;;) {
        const bool has_next = S.next(ui + 1, nxt);
        const char* nA = has_next ? (const char*)g.A + (size_t)nxt.pm * tstepA + (size_t)nxt.kofs * 2 : cA; const char* nB = has_next ? (const char*)g.Bt + (size_t)nxt.pn * tstepB + (size_t)nxt.kofs * 2 : cB;
        const int nt = cur.nt;
        for (int t = 0; t < nt; t += 2) {
            const bool last = (t == nt - 2);
            const char* a1 = cA + (size_t)(t + 1) * kstep;
            const char* a2 = last ? nA : cA + (size_t)(t + 2) * kstep; const char* b2 = last ? nB : cB + (size_t)(t + 2) * kstep;
            const char* a3 = a2 + kstep; const char* b3 = b2 + kstep;
            PG8_LDB(B0, 0, 0); PG8_LDB(B1, 0, 1); PG8_SCHED; PG8_LDA(At, 0, 0); PG8_STAGE(PG8_SA(1, 1), a1 + hstepA, voffA);
            PG8_WAIT_V(8); PG8_WAIT_L(0); PG8_BAR; PG8_MMA(0, 0, At, B0); PG8_MMA(0, 1, At, B1); PG8_BAR; PG8_SCHED;
            PG8_LDA(At, 0, 1); PG8_STAGE(PG8_SB(0, 0), b2, voffB); PG8_STAGE(PG8_SB(0, 1), b2 + hstepB, voffB); PG8_STAGE(PG8_SA(0, 0), a2, voffA);
            PG8_WAIT_V(8); PG8_WAIT_L(0); PG8_BAR; PG8_MMA(1, 0, At, B0); PG8_MMA(1, 1, At, B1); PG8_BAR; PG8_SCHED;
            PG8_LDB(B0, 1, 0); PG8_LDB(B1, 1, 1); PG8_SCHED; PG8_LDA(At, 1, 0); PG8_STAGE(PG8_SA(0, 1), a2 + hstepA, voffA);
            PG8_WAIT_V(8); PG8_WAIT_L(0); PG8_BAR; PG8_MMA(0, 0, At, B0); PG8_MMA(0, 1, At, B1); PG8_BAR; PG8_SCHED;
            PG8_LDA(At, 1, 1); PG8_STAGE(PG8_SB(1, 0), b3, voffB); PG8_STAGE(PG8_SB(1, 1), b3 + hstepB, voffB); PG8_STAGE(PG8_SA(1, 0), a3, voffA);
            PG8_WAIT_V(8); PG8_WAIT_L(0); PG8_BAR; PG8_MMA(1, 0, At, B0); PG8_MMA(1, 1, At, B1); PG8_BAR; PG8_SCHED;
        }
        if (wr == 0) PG8_BAR;
        if (PERM) {
            if ((PERM_MASK & 1) && E.kind == EK_SWIGLU) epilogue_p<EK_SWIGLU>(acc, cur, E, C, wr, wc, fr, fq);
            else if ((PERM_MASK & 2) && E.kind == EK_RESID) epilogue_p<EK_RESID>(acc, cur, E, C, wr, wc, fr, fq);
            else if ((PERM_MASK & 4) && E.kind == EK_PROJ) epilogue_p<EK_PROJ>(acc, cur, E, C, wr, wc, fr, fq);
            else if ((PERM_MASK & 8) && E.kind == EK_BRANCH) epilogue_p<EK_BRANCH>(acc, cur, E, C, wr, wc, fr, fq);
        } else {
            if (!(PERM_MASK & 1) && E.kind == EK_SWIGLU) epilogue<EK_SWIGLU>(acc, cur, E, C, wr, wc, fr, fq);
            else if (!(PERM_MASK & 2) && E.kind == EK_RESID) epilogue<EK_RESID>(acc, cur, E, C, wr, wc, fr, fq);
            else if (!(PERM_MASK & 4) && E.kind == EK_PROJ) epilogue<EK_PROJ>(acc, cur, E, C, wr, wc, fr, fq);
            else if (!(PERM_MASK & 8) && E.kind == EK_BRANCH) epilogue<EK_BRANCH>(acc, cur, E, C, wr, wc, fr, fq);
        }
        if (!has_next) break;
#pragma unroll
        for (int a = 0; a < 2; ++a)
#pragma unroll
            for (int b = 0; b < 2; ++b)
#pragma unroll
                for (int m = 0; m < 4; ++m)
#pragma unroll
                    for (int n = 0; n < 2; ++n) acc[a][b][m][n] = (f32x4){0.f, 0.f, 0.f, 0.f};
        cur = nxt; cA = nA; cB = nB; ++ui;
        if (wr == 1) PG8_BAR;
    }
    PG8_WAIT_V(0);
    PG8_BAR;
#undef PG8_SA
#undef PG8_SB
#undef PG8_STAGE
#undef PG8_LDA
#undef PG8_LDB
#undef PG8_MMA
#undef PG8_WAIT_V
#undef PG8_WAIT_L
#undef PG8_BAR
#undef PG8_SCHED
}
__device__ __forceinline__ void small_unit(const Gemm g, const EpiDesc& E, const Ctx& C, int su, unsigned char* shm) {
    const int tid = opaque_tid(), lane = tid & 63, w = __builtin_amdgcn_readfirstlane(tid >> 6), m = lane & 31, hi = lane >> 5;
    const int row0 = 16384 + 64 * (su >> 4), col0 = 64 * (su & 15);
    int k_lo, k_len;
    if (E.kind == EK_BRANCH) { k_len = 128; k_lo = 128 * w; }
    else { k_len = (E.kind == EK_RESID && g.lda == DFF) ? DFF / 8 : DM / 8; k_lo = k_len * w; }
    const bf16_t* ap = g.A + (size_t)(row0 + m) * g.lda + k_lo + 8 * hi;
    const bf16_t* bp = g.Bt + (size_t)(col0 + m) * g.ldb + k_lo + 8 * hi;
    const size_t a32 = (size_t)32 * g.lda, b32 = (size_t)32 * g.ldb;
    f32x16 acc[2][2];
#pragma unroll
    for (int i = 0; i < 2; ++i)
#pragma unroll
        for (int j = 0; j < 2; ++j)
#pragma unroll
            for (int r = 0; r < 16; ++r) acc[i][j][r] = 0.f;
    const int nsteps = k_len >> 5;
    for (int s0 = 0; s0 < nsteps; s0 += 4) {
        bf16x8 fa[4][4], fb[4][4];
#pragma unroll
        for (int u = 0; u < 4; ++u) {
            const int k = 32 * min(s0 + u, nsteps - 1);
            fa[u][0] = *(const bf16x8*)(ap + k); fa[u][1] = *(const bf16x8*)(ap + a32 + k); fa[u][2] = *(const bf16x8*)(ap + k + 16); fa[u][3] = *(const bf16x8*)(ap + a32 + k + 16);
            fb[u][0] = *(const bf16x8*)(bp + k); fb[u][1] = *(const bf16x8*)(bp + b32 + k); fb[u][2] = *(const bf16x8*)(bp + k + 16); fb[u][3] = *(const bf16x8*)(bp + b32 + k + 16);
        }
#pragma unroll
        for (int u = 0; u < 4; ++u) {
            if (s0 + u < nsteps) {
                acc[0][0] = __builtin_amdgcn_mfma_f32_32x32x16_bf16(fa[u][0], fb[u][0], acc[0][0], 0, 0, 0); acc[0][1] = __builtin_amdgcn_mfma_f32_32x32x16_bf16(fa[u][0], fb[u][1], acc[0][1], 0, 0, 0);
                acc[1][0] = __builtin_amdgcn_mfma_f32_32x32x16_bf16(fa[u][1], fb[u][0], acc[1][0], 0, 0, 0); acc[1][1] = __builtin_amdgcn_mfma_f32_32x32x16_bf16(fa[u][1], fb[u][1], acc[1][1], 0, 0, 0);
                acc[0][0] = __builtin_amdgcn_mfma_f32_32x32x16_bf16(fa[u][2], fb[u][2], acc[0][0], 0, 0, 0); acc[0][1] = __builtin_amdgcn_mfma_f32_32x32x16_bf16(fa[u][2], fb[u][3], acc[0][1], 0, 0, 0);
                acc[1][0] = __builtin_amdgcn_mfma_f32_32x32x16_bf16(fa[u][3], fb[u][2], acc[1][0], 0, 0, 0); acc[1][1] = __builtin_amdgcn_mfma_f32_32x32x16_bf16(fa[u][3], fb[u][3], acc[1][1], 0, 0, 0);
            }
        }
    }
    float* P = (float*)shm + w * 4096;
#pragma unroll
    for (int i = 0; i < 2; ++i)
#pragma unroll
        for (int j = 0; j < 2; ++j)
#pragma unroll
            for (int r = 0; r < 16; ++r) P[(32 * i + crow(r, hi)) * 64 + 32 * j + m] = acc[i][j][r];
    __syncthreads();
    {
        const int r = tid >> 3, cg8 = (tid & 7) * 8, row = row0 + r, col = col0 + cg8;
        const float* pp = (const float*)shm + r * 64 + cg8;
        f32x4 v0, v1;
        if (E.kind == EK_BRANCH) {
            const bf16_t* gp = C.G + (size_t)row * 3072 + col;
            f32x4 s0 = *(const f32x4*)(pp) + *(const f32x4*)(pp + 4096), s1 = *(const f32x4*)(pp + 4) + *(const f32x4*)(pp + 4096 + 4);
            f32x4 t0 = *(const f32x4*)(pp + 2 * 4096) + *(const f32x4*)(pp + 3 * 4096), t1 = *(const f32x4*)(pp + 2 * 4096 + 4) + *(const f32x4*)(pp + 3 * 4096 + 4);
            f32x4 u0 = (*(const f32x4*)(pp + 4 * 4096) + *(const f32x4*)(pp + 5 * 4096)) + (*(const f32x4*)(pp + 6 * 4096) + *(const f32x4*)(pp + 7 * 4096));
            f32x4 u1 = (*(const f32x4*)(pp + 4 * 4096 + 4) + *(const f32x4*)(pp + 5 * 4096 + 4)) + (*(const f32x4*)(pp + 6 * 4096 + 4) + *(const f32x4*)(pp + 7 * 4096 + 4));
            const u32x4 ga = *(const u32x4*)(gp), gb = *(const u32x4*)(gp + 1024), gc = *(const u32x4*)(gp + 2048);
            v0 = s0 * unpk4((u32x2){ga.x, ga.y}) + t0 * unpk4((u32x2){gb.x, gb.y}) + u0 * unpk4((u32x2){gc.x, gc.y});
            v1 = s1 * unpk4((u32x2){ga.z, ga.w}) + t1 * unpk4((u32x2){gb.z, gb.w}) + u1 * unpk4((u32x2){gc.z, gc.w});
            const u32x2 p0 = pk4(v0), p1 = pk4(v1);
            *(u32x4*)(C.MIXB + (size_t)row * DM + col) = (u32x4){p0.x, p0.y, p1.x, p1.y};
        } else {
            v0 = (f32x4){0.f, 0.f, 0.f, 0.f}; v1 = v0;
#pragma unroll
            for (int ww = 0; ww < 8; ++ww) { v0 = v0 + *(const f32x4*)(pp + ww * 4096); v1 = v1 + *(const f32x4*)(pp + ww * 4096 + 4); }
            const u32x4 hb = *(const u32x4*)(C.XB + (size_t)row * DM + col);
            const f32x4 h0 = unpk4((u32x2){hb.x, hb.y}) + v0 * E.alpha, h1 = unpk4((u32x2){hb.z, hb.w}) + v1 * E.alpha;
            const u32x2 p0 = pk4(h0), p1 = pk4(h1);
            if (!E.final_) *(u32x4*)(C.XB + (size_t)row * DM + col) = (u32x4){p0.x, p0.y, p1.x, p1.y};
            if (E.final_) {
                float* dst = nullptr;
                if (row < NPR) { const int b = row / TP, t = row - b * TP; if (t >= 16) dst = C.out + OFF_YP + ((size_t)b * 4096 + (t - 16)) * 1024; }
                else dst = C.out + OFF_YS + (size_t)(row - NPR) * 1024;
                if (dst) { *(f32x4*)(dst + col) = h0; *(f32x4*)(dst + col + 4) = h1; }
            }
            float ss = h0[0] * h0[0] + h0[1] * h0[1] + h0[2] * h0[2] + h0[3] * h0[3] + h1[0] * h1[0] + h1[1] * h1[1] + h1[2] * h1[2] + h1[3] * h1[3];
            ss += __shfl_xor(ss, 1); ss += __shfl_xor(ss, 2); ss += __shfl_xor(ss, 4);
            if ((tid & 7) == 0) unsafeAtomicAdd(E.rss_out + row, ss);
        }
    }
    __syncthreads();
}
}

__device__ __forceinline__ float wave_sum(float v) {
#pragma unroll
    for (int o = 1; o < 64; o <<= 1) v += __shfl_xor(v, o);
    return v;
}
__device__ __forceinline__ const float* src_col(int kind, const float* W, const float* W2, int c) {
    if (kind == 1) { if (PERM_MASK & 1) { const int pn = c >> 8, sl = c & 255; return ((sl >> 7) ? W2 : W) + 128 * pn + (sl & 127); } const int Gc = c >> 5, n = (c >> 4) & 1, i = c & 15; return (n ? W2 : W) + 16 * Gc + i; }
    if (kind == 2) { const int pn = c >> 8; if (pn >= 4 && pn < 8) { const int s = c & 255, hl = (s >> 5) & 3, d = 32 * (s >> 7) + (s & 31); return W + 256 * pn + 64 * hl + d; } return W + c; }
    return W + c;
}
__device__ __forceinline__ void transpose_item(int kind, const float* W, const float* W2, int srcN, const float* gain, bf16_t* WT, int ldt, int kb, int cb, float* scr, int lane) {
    const int k0 = 64 * kb, c0 = 64 * cb, c4 = (lane & 15) * 4, kr = lane >> 4;
    const float* p = src_col(kind, W, W2, c0 + c4) + (size_t)(k0 + kr) * srcN;
    f32x4 v[16];
#pragma unroll
    for (int i = 0; i < 16; ++i) v[i] = *(const f32x4*)(p + (size_t)(4 * i) * srcN);
#pragma unroll
    for (int i = 0; i < 16; ++i) {
        const int kk = 4 * i + kr; const float gs = gain ? gain[k0 + kk] : 1.f;
        float* d = scr + kk * 65 + c4;
        d[0] = v[i][0] * gs; d[1] = v[i][1] * gs; d[2] = v[i][2] * gs; d[3] = v[i][3] * gs;
    }
    asm volatile("s_waitcnt lgkmcnt(0)" ::: "memory");
    const int c8 = lane & 7;
#pragma unroll
    for (int j = 0; j < 8; ++j) { const int n = (lane >> 3) + 8 * j; const float* s = scr + (8 * c8) * 65 + n;
        u32x4 o; o.x = cvt_pk_bf16(s[0 * 65], s[1 * 65]); o.y = cvt_pk_bf16(s[2 * 65], s[3 * 65]); o.z = cvt_pk_bf16(s[4 * 65], s[5 * 65]); o.w = cvt_pk_bf16(s[6 * 65], s[7 * 65]);
        *(u32x4*)(WT + (size_t)(c0 + n) * ldt + k0 + 8 * c8) = o; }
    asm volatile("s_waitcnt lgkmcnt(0)" ::: "memory");
}

constexpr int I_GU = 16 * 88, I_DN = 44 * 16, I_IN = 16 * 88, I_BP = 4 * 16, I_BA = 8 * 16, I_OUT = 16 * 16;
constexpr int I_LAYER = 2 * I_GU + 2 * I_DN + I_IN + 2 * I_BP + I_BA + I_OUT;
__device__ __forceinline__ void convert_items(const Ctx& C, unsigned char* shm, int it_lo, int it_hi, int gw0, int ngw) {
    const int tid = opaque_tid(), lane = tid & 63, wave = tid >> 6;
    float* scr = (float*)(shm + wave * 16640);
    for (int it = it_lo + gw0; it < it_hi; it += ngw) {
        const int l = it / I_LAYER; int r = it - l * I_LAYER;
        unsigned char* wl = C.ws + WS_W + (size_t)l * W_LAYER;
        if (r < I_GU) { transpose_item(1, C.in[8] + (size_t)l * DM * DFF, C.in[9] + (size_t)l * DM * DFF, DFF, C.in[7] + l * DM, (bf16_t*)(wl + W_GU1), DM, r / 88, r % 88, scr, lane); continue; } r -= I_GU;
        if (r < I_GU) { transpose_item(1, C.in[23] + (size_t)l * DM * DFF, C.in[24] + (size_t)l * DM * DFF, DFF, C.in[22] + l * DM, (bf16_t*)(wl + W_GU2), DM, r / 88, r % 88, scr, lane); continue; } r -= I_GU;
        if (r < I_DN) { transpose_item(0, C.in[10] + (size_t)l * DFF * DM, nullptr, DM, nullptr, (bf16_t*)(wl + W_DN1), DFF, r / 16, r % 16, scr, lane); continue; } r -= I_DN;
        if (r < I_DN) { transpose_item(0, C.in[25] + (size_t)l * DFF * DM, nullptr, DM, nullptr, (bf16_t*)(wl + W_DN2), DFF, r / 16, r % 16, scr, lane); continue; } r -= I_DN;
        if (r < I_IN) { transpose_item(2, C.in[12] + (size_t)l * DM * NIN, nullptr, NIN, C.in[11] + l * DM, (bf16_t*)(wl + W_IN), DM, r / 88, r % 88, scr, lane); continue; } r -= I_IN;
        if (r < I_BP) { transpose_item(0, C.in[15] + (size_t)l * 256 * DM, nullptr, DM, nullptr, (bf16_t*)(wl + W_BR), DM, r / 16, r % 16, scr, lane); continue; } r -= I_BP;
        if (r < I_BP) { transpose_item(0, C.in[17] + (size_t)l * 256 * DM, nullptr, DM, nullptr, (bf16_t*)(wl + W_BR) + 256, DM, r / 16, r % 16, scr, lane); continue; } r -= I_BP;
        if (r < I_BA) { transpose_item(0, C.in[20] + (size_t)l * 512 * DM, nullptr, DM, nullptr, (bf16_t*)(wl + W_BR) + 512, DM, r / 16, r % 16, scr, lane); continue; } r -= I_BA;
        transpose_item(0, C.in[21] + (size_t)l * DM * DM, nullptr, DM, nullptr, (bf16_t*)(wl + W_OUT), DM, r / 16, r % 16, scr, lane);
    }
}

__device__ __forceinline__ void prologue_phase(const Ctx& C, unsigned char* shm) {
    const int tid = opaque_tid(), lane = tid & 63, wave = tid >> 6;
    const int gw = blockIdx.x * 8 + wave, NGW = gridDim.x * 8;
    convert_items(C, shm, 0, (gridDim.x > 160) ? I_LAYER : 2 * I_LAYER, gw, NGW);
    for (int m = gw; m < MP; m += NGW) {
        f32x4 v[4];
        if (m < MR) {
            const float* src;
            if (m < NPR) { const int b = m / TP, t = m - b * TP; src = (t < 16) ? C.in[6] + (size_t)t * DM : C.in[0] + ((size_t)b * 4096 + (t - 16)) * DM; }
            else src = C.in[1] + (size_t)(m - NPR) * DM;
#pragma unroll
            for (int j = 0; j < 4; ++j) v[j] = *((const f32x4*)src + lane + 64 * j);
        } else {
#pragma unroll
            for (int j = 0; j < 4; ++j) v[j] = (f32x4){0.f, 0.f, 0.f, 0.f};
        }
        float s = 0.f;
#pragma unroll
        for (int j = 0; j < 4; ++j) { s += v[j][0] * v[j][0] + v[j][1] * v[j][1] + v[j][2] * v[j][2] + v[j][3] * v[j][3];
            *((u32x2*)(C.XB + (size_t)m * DM) + lane + 64 * j) = pk4(v[j]); }
        s = wave_sum(s);
        if (lane == 0) C.RSS[m] = s;
        if (lane >= 1 && lane < 7) C.RSS[(size_t)lane * MP + m] = 0.f;
    }
}

typedef float f32x2 __attribute__((ext_vector_type(2)));
template <bool MASK>
__device__ __forceinline__ void sb_math(const f32x16& st, int kb, int tq, int hi, float& carry, bf16x8& p0, bf16x8& p1) {
    f32x2 e2[8], x2[8];
#pragma unroll
    for (int p = 0; p < 8; ++p) {
        float e0 = __builtin_amdgcn_exp2f(st[2 * p]), e1 = __builtin_amdgcn_exp2f(st[2 * p + 1]);
        if (MASK) { const int key = kb + crow(2 * p, hi); e0 = (key >= 0 && key < tq) ? e0 : 0.f; e1 = (key + 1 >= 0 && key + 1 < tq) ? e1 : 0.f; }
        e2[p] = (f32x2){e0, e1};
        const f32x2 d = e2[p] + (f32x2){1.f, 1.f};
        x2[p] = (f32x2){__builtin_amdgcn_rcpf(d.x), __builtin_amdgcn_rcpf(d.y)};
    }
    float g0[4], g1[4];
#pragma unroll
    for (int c = 0; c < 4; ++c) {
        const float X3 = x2[2 * c + 1].y, X2 = x2[2 * c + 1].x * X3, X1 = x2[2 * c].y * X2, X0 = x2[2 * c].x * X1;
        x2[2 * c] = (f32x2){X0, X1}; x2[2 * c + 1] = (f32x2){X2, X3};
        auto rr = __builtin_amdgcn_permlane32_swap(__float_as_uint(X0), __float_as_uint(X0), false, false);
        g0[c] = __uint_as_float(rr[0]); g1[c] = __uint_as_float(rr[1]);
    }
    const float T7 = carry, T6 = T7 * g1[3], T5 = T6 * g0[3], T4 = T5 * g1[2], T3 = T4 * g0[2], T2 = T3 * g1[1], T1 = T2 * g0[1], T0 = T1 * g1[0];
    carry = T0 * g0[0];
    const float t0 = hi ? T1 : T0, t1 = hi ? T3 : T2, t2 = hi ? T5 : T4, t3 = hi ? T7 : T6;
    f32x2 a2[8];
    { const f32x2 tb = (f32x2){t0, t0}; a2[0] = e2[0] * (x2[0] * tb); a2[1] = e2[1] * (x2[1] * tb); }
    { const f32x2 tb = (f32x2){t1, t1}; a2[2] = e2[2] * (x2[2] * tb); a2[3] = e2[3] * (x2[3] * tb); }
    { const f32x2 tb = (f32x2){t2, t2}; a2[4] = e2[4] * (x2[4] * tb); a2[5] = e2[5] * (x2[5] * tb); }
    { const f32x2 tb = (f32x2){t3, t3}; a2[6] = e2[6] * (x2[6] * tb); a2[7] = e2[7] * (x2[7] * tb); }
    u32x4 q0, q1;
    q0.x = cvt_pk_bf16(a2[0].x, a2[0].y); q0.y = cvt_pk_bf16(a2[1].x, a2[1].y); q0.z = cvt_pk_bf16(a2[2].x, a2[2].y); q0.w = cvt_pk_bf16(a2[3].x, a2[3].y);
    q1.x = cvt_pk_bf16(a2[4].x, a2[4].y); q1.y = cvt_pk_bf16(a2[5].x, a2[5].y); q1.z = cvt_pk_bf16(a2[6].x, a2[6].y); q1.w = cvt_pk_bf16(a2[7].x, a2[7].y);
    p0 = __builtin_bit_cast(bf16x8, q0); p1 = __builtin_bit_cast(bf16x8, q1);
}

constexpr int AT_KROW = 144, AT_VROW = 136, AT_KBYTES = 64 * AT_KROW, AT_BUF = AT_KBYTES + 64 * AT_VROW;

__device__ __forceinline__ void attn_main_unit(const Ctx& C, int b, int h, int j, unsigned char* shm) {
    const int tid = opaque_tid(), lane = tid & 63, qi = lane & 31, hi = lane >> 5, w = __builtin_amdgcn_readfirstlane(tid >> 6);
    const int tq0 = 16 + 256 * j + 32 * w, tq = tq0 + qi;
    const size_t qrow = (size_t)b * TP + tq;
    bf16x8 qf[4];
#pragma unroll
    for (int s = 0; s < 4; ++s) qf[s] = *(const bf16x8*)(C.Q + qrow * 512 + 64 * h + 16 * s + 8 * hi);
    f32x16 o0, o1;
#pragma unroll
    for (int r = 0; r < 16; ++r) { o0[r] = 0.f; o1[r] = 0.f; }
    float carry = 1.f;
    const int itop = 4 * j + 4, wtop = 4 * j + (32 * w + 94) / 64;
    const int srow = tid >> 3, sch = tid & 7;
    const bf16_t* kg = C.KP + ((ptrdiff_t)b * TP - 48 + srow) * 512 + 64 * h + 8 * sch;
    const bf16_t* vg = C.VB + ((ptrdiff_t)b * TP - 48 + srow) * 512 + 64 * h + 8 * sch;
    u32x4 kreg = *(const u32x4*)(kg + (size_t)itop * 64 * 512), vreg = *(const u32x4*)(vg + (size_t)itop * 64 * 512);
    unsigned* flg = (unsigned*)(shm + 2 * AT_BUF);
    if (tid < 2) flg[tid] = 0u;
    bool wdone = false;
    for (int i = itop; i >= 0; --i) {
        unsigned char* kb_ = shm + (i & 1) * AT_BUF; unsigned char* vb_ = kb_ + AT_KBYTES;
        *(u32x4*)(kb_ + srow * AT_KROW + sch * 16) = kreg;
        {
            bf16_t* vw = (bf16_t*)(vb_ + (8 * sch) * AT_VROW + srow * 2);
            vw[0 * (AT_VROW / 2)] = (bf16_t)(vreg.x & 0xffffu); vw[1 * (AT_VROW / 2)] = (bf16_t)(vreg.x >> 16);
            vw[2 * (AT_VROW / 2)] = (bf16_t)(vreg.y & 0xffffu); vw[3 * (AT_VROW / 2)] = (bf16_t)(vreg.y >> 16);
            vw[4 * (AT_VROW / 2)] = (bf16_t)(vreg.z & 0xffffu); vw[5 * (AT_VROW / 2)] = (bf16_t)(vreg.z >> 16);
            vw[6 * (AT_VROW / 2)] = (bf16_t)(vreg.w & 0xffffu); vw[7 * (AT_VROW / 2)] = (bf16_t)(vreg.w >> 16);
        }
        if (i > 0) { kreg = *(const u32x4*)(kg + (size_t)(i - 1) * 64 * 512); vreg = *(const u32x4*)(vg + (size_t)(i - 1) * 64 * 512); }
        asm volatile("s_waitcnt lgkmcnt(0)" ::: "memory"); __builtin_amdgcn_s_barrier(); asm volatile("" ::: "memory");
        if (i < itop) { const unsigned fw = (unsigned)__builtin_amdgcn_readfirstlane((int)((volatile unsigned*)flg)[(i + 1) & 1]); if (fw == 0xFFu) break; }
        if (i <= wtop && !wdone) {
#pragma unroll
            for (int sub = 1; sub >= 0; --sub) {
                const int kb = 64 * i - 48 + 32 * sub;
                if (kb > tq0 + 30 || kb + 31 < 0) continue;
                const bool need_mask = (kb + 31 >= tq0) || (kb < 0);
                f32x16 st;
#pragma unroll
                for (int r = 0; r < 16; ++r) st[r] = 0.f;
#pragma unroll
                for (int s = 0; s < 4; ++s) { const bf16x8 kf = *(const bf16x8*)(kb_ + (32 * sub + qi) * AT_KROW + 32 * s + 16 * hi); st = __builtin_amdgcn_mfma_f32_32x32x16_bf16(kf, qf[s], st, 0, 0, 0); }
                bf16x8 p0, p1;
                if (need_mask) sb_math<true>(st, kb, tq, hi, carry, p0, p1); else sb_math<false>(st, kb, tq, hi, carry, p0, p1);
#pragma unroll
                for (int s = 0; s < 2; ++s) {
                    const unsigned char* vp0 = vb_ + qi * AT_VROW + (32 * sub + 16 * s + 4 * hi) * 2;
                    const unsigned char* vp1 = vp0 + 32 * AT_VROW;
                    const s16x4 a0 = *(const s16x4*)vp0, a1 = *(const s16x4*)(vp0 + 16), b0 = *(const s16x4*)vp1, b1 = *(const s16x4*)(vp1 + 16);
                    const bf16x8 v0 = (bf16x8){a0[0], a0[1], a0[2], a0[3], a1[0], a1[1], a1[2], a1[3]}, v1 = (bf16x8){b0[0], b0[1], b0[2], b0[3], b1[0], b1[1], b1[2], b1[3]};
                    o0 = __builtin_amdgcn_mfma_f32_32x32x16_bf16(v0, s ? p1 : p0, o0, 0, 0, 0);
                    o1 = __builtin_amdgcn_mfma_f32_32x32x16_bf16(v1, s ? p1 : p0, o1, 0, 0, 0);
                }
            }
            wdone = (__builtin_amdgcn_ballot_w64(carry != 0.f) == 0ull);
        }
        if (wdone && lane == 0) __hip_atomic_fetch_or(flg + (i & 1), 1u << w, __ATOMIC_RELAXED, __HIP_MEMORY_SCOPE_WORKGROUP);
    }
    bf16_t* op = C.PRE + qrow * DM + 512 + 64 * h + 4 * hi;
#pragma unroll
    for (int c = 0; c < 4; ++c) {
        *(u32x2*)(op + 8 * c) = (u32x2){cvt_pk_bf16(o0[4 * c], o0[4 * c + 1]), cvt_pk_bf16(o0[4 * c + 2], o0[4 * c + 3])};
        *(u32x2*)(op + 32 + 8 * c) = (u32x2){cvt_pk_bf16(o1[4 * c], o1[4 * c + 1]), cvt_pk_bf16(o1[4 * c + 2], o1[4 * c + 3])};
    }
    __syncthreads();
}

__device__ __forceinline__ void attn_skinny_unit(const Ctx& C, const float* k0, const float* v0, const float* k1, const float* v1, int S0, int S, int tq_base, size_t qrow_base, int h, unsigned char* shm) {
    const int tid = opaque_tid(), lane = tid & 63, qi = lane & 31, hi = lane >> 5, w = __builtin_amdgcn_readfirstlane(tid >> 6), q16 = qi & 15;
    const int tq = tq_base + q16;
    bf16x8 qf[4];
#pragma unroll
    for (int s = 0; s < 4; ++s) qf[s] = *(const bf16x8*)(C.Q + (qrow_base + q16) * 512 + 64 * h + 16 * s + 8 * hi);
    f32x16 o0, o1;
#pragma unroll
    for (int r = 0; r < 16; ++r) { o0[r] = 0.f; o1[r] = 0.f; }
    float carry = 1.f;
    const int nsb = (S + 31) >> 5, per = (nsb + 7) >> 3, sb_lo = w * per, sb_hi = min(nsb, sb_lo + per);
    for (int sb = sb_hi - 1; sb >= sb_lo; --sb) {
        const int kb = 32 * sb;
        const int key = min(kb + qi, S - 1);
        const float* kr = (key < S0 ? k0 + (size_t)key * 512 : k1 + (size_t)(key - S0) * 512) + 64 * h + 8 * hi;
        f32x16 st;
#pragma unroll
        for (int r = 0; r < 16; ++r) st[r] = 0.f;
#pragma unroll
        for (int s = 0; s < 4; ++s) {
            const f32x4 a = *(const f32x4*)(kr + 16 * s), bq = *(const f32x4*)(kr + 16 * s + 4);
            u32x4 pk; pk.x = cvt_pk_bf16(a[0], a[1]); pk.y = cvt_pk_bf16(a[2], a[3]); pk.z = cvt_pk_bf16(bq[0], bq[1]); pk.w = cvt_pk_bf16(bq[2], bq[3]);
            st = __builtin_amdgcn_mfma_f32_32x32x16_bf16(__builtin_bit_cast(bf16x8, pk), qf[s], st, 0, 0, 0);
        }
        bf16x8 p0, p1;
        sb_math<true>(st, kb, tq, hi, carry, p0, p1);
#pragma unroll
        for (int s = 0; s < 2; ++s) {
            float va[8], vb[8];
#pragma unroll
            for (int jj = 0; jj < 8; ++jj) {
                const int kk = min(kb + 16 * s + 4 * hi + (jj < 4 ? jj : jj + 4), S - 1);
                const float* vr = (kk < S0 ? v0 + (size_t)kk * 512 : v1 + (size_t)(kk - S0) * 512) + 64 * h + qi;
                va[jj] = vr[0]; vb[jj] = vr[32];
            }
            u32x4 pa, pb;
            pa.x = cvt_pk_bf16(va[0], va[1]); pa.y = cvt_pk_bf16(va[2], va[3]); pa.z = cvt_pk_bf16(va[4], va[5]); pa.w = cvt_pk_bf16(va[6], va[7]);
            pb.x = cvt_pk_bf16(vb[0], vb[1]); pb.y = cvt_pk_bf16(vb[2], vb[3]); pb.z = cvt_pk_bf16(vb[4], vb[5]); pb.w = cvt_pk_bf16(vb[6], vb[7]);
            o0 = __builtin_amdgcn_mfma_f32_32x32x16_bf16(__builtin_bit_cast(bf16x8, pa), s ? p1 : p0, o0, 0, 0, 0);
            o1 = __builtin_amdgcn_mfma_f32_32x32x16_bf16(__builtin_bit_cast(bf16x8, pb), s ? p1 : p0, o1, 0, 0, 0);
        }
    }
    float* OW = (float*)shm;
    float* RW = OW + 8 * 16 * 64;
    if (qi < 16) {
#pragma unroll
        for (int r = 0; r < 16; ++r) { OW[(w * 16 + qi) * 64 + crow(r, hi)] = o0[r]; OW[(w * 16 + qi) * 64 + 32 + crow(r, hi)] = o1[r]; }
        if (hi == 0) RW[w * 16 + qi] = carry;
    }
    __syncthreads();
    {
        const int q = tid >> 5, d = (tid & 31) * 2;
        float c = 1.f, a0 = 0.f, a1 = 0.f;
#pragma unroll
        for (int ww = 7; ww >= 0; --ww) { a0 += OW[(ww * 16 + q) * 64 + d] * c; a1 += OW[(ww * 16 + q) * 64 + d + 1] * c; c *= RW[ww * 16 + q]; }
        *(unsigned*)(C.PRE + (qrow_base + q) * DM + 512 + 64 * h + d) = cvt_pk_bf16(a0, a1);
    }
    __syncthreads();
}

template <int MODE>
__device__ __forceinline__ void poolconv_wave(const Ctx& C, int l, int ch, int g, int lane, float* PL) {
    constexpr bool samp = (MODE == 2);
    const int b = samp ? ch - 1028 : ch / 257, t0 = samp ? 0 : 16 * (ch % 257);
    const size_t rowbase = samp ? (size_t)NPR + 16 * b : (size_t)b * TP + t0;
    const int pos0 = samp ? 1024 : 0, c = 64 * g + lane, wnd = 2 << g;
    const float* spool = C.in[4] + ((size_t)l * 32 + b) * 15 * 256;
    const float* sconv = C.in[5] + ((size_t)l * 32 + b) * 2 * 256;
    float s[31], a[16];
#pragma unroll
    for (int r = 0; r < 31; ++r) {
        float v;
        if (MODE == 0) v = bf2f(C.PAB[(rowbase + (r - 15)) * DM + c]);
        else if (r >= 15) v = bf2f(C.PAB[(rowbase + (r - 15)) * DM + c]);
        else if (MODE == 2) v = spool[r * 256 + c];
        else v = 0.f;
        s[r] = v;
    }
#pragma unroll
    for (int i = 0; i < 16; ++i) a[i] = s[15 + i];
#pragma unroll
    for (int i = 30; i >= 1; --i) s[i] += s[i - 1];
    if (g >= 1) {
#pragma unroll
        for (int i = 30; i >= 3; --i) s[i] += s[i - 2];
    }
    if (g >= 2) {
#pragma unroll
        for (int i = 30; i >= 7; --i) s[i] += s[i - 4];
    }
    if (g >= 3) {
#pragma unroll
        for (int i = 30; i >= 15; --i) s[i] += s[i - 8];
    }
    float p[16], acc[16];
#pragma unroll
    for (int i = 0; i < 16; ++i) { const int pos = pos0 + t0 + i; p[i] = s[15 + i] / (float)min(pos + 1, wnd) - a[i]; acc[i] = 0.f; }
    const float* wp = C.in[13] + ((size_t)l * 4 + g) * 4096 + lane;
#pragma unroll
    for (int i = 0; i < 16; ++i) PL[i * 64 + lane] = p[i];
    asm volatile("s_waitcnt lgkmcnt(0)" ::: "memory");
#pragma unroll 2
    for (int k4 = 0; k4 < 16; ++k4) {
        const float w0 = wp[(4 * k4 + 0) * 64], w1 = wp[(4 * k4 + 1) * 64], w2 = wp[(4 * k4 + 2) * 64], w3 = wp[(4 * k4 + 3) * 64];
#pragma unroll
        for (int i = 0; i < 16; ++i) { const f32x4 pv = *(const f32x4*)(PL + i * 64 + 4 * k4); acc[i] += pv[0] * w0 + pv[1] * w1 + pv[2] * w2 + pv[3] * w3; }
    }
    asm volatile("s_waitcnt lgkmcnt(0)" ::: "memory");
    const float sc = C.in[14][l * 256 + c];
    const bool st_out = samp || t0 == 4096;
    float* pout = C.out + (samp ? OFF_PS + ((size_t)l * 32 + b) * 15 * 256 : OFF_PP + ((size_t)l * 4 + b) * 15 * 256) + c;
#pragma unroll
    for (int i = 0; i < 16; ++i) {
        C.PRE[(rowbase + i) * DM + c] = (bf16_t)(cvt_pk_bf16(acc[i] * sc, 0.f) & 0xffffu);
        if (st_out && i >= 1) pout[(i - 1) * 256] = a[i];
    }
    const float cw0 = C.in[16][(l * 3 + 0) * 256 + c], cw1 = C.in[16][(l * 3 + 1) * 256 + c], cw2 = C.in[16][(l * 3 + 2) * 256 + c];
    float e[18], gb[16];
#pragma unroll
    for (int i = 0; i < 18; ++i) {
        float v;
        if (MODE == 0 || i >= 2) { const bf16_t* r = C.PAB + (rowbase + (i - 2)) * DM; v = bf2f(r[768 + c]) * bf2f(r[256 + c]); }
        else if (MODE == 2) v = sconv[i * 256 + c];
        else v = 0.f;
        e[i] = v;
    }
#pragma unroll
    for (int i = 0; i < 16; ++i) gb[i] = bf2f(C.PAB[(rowbase + i) * DM + 512 + c]);
    float* cout = C.out + (samp ? OFF_CS + ((size_t)l * 32 + b) * 2 * 256 : OFF_CP + ((size_t)l * 4 + b) * 2 * 256) + c;
#pragma unroll
    for (int i = 0; i < 16; ++i) {
        const float y = gb[i] * (cw0 * e[i] + cw1 * e[i + 1] + cw2 * e[i + 2]);
        C.PRE[(rowbase + i) * DM + 256 + c] = (bf16_t)(cvt_pk_bf16(y, 0.f) & 0xffffu);
        if (st_out && i >= 14) cout[(i - 14) * 256] = e[i + 2];
    }
}

__device__ __forceinline__ void mixers_phase(const Ctx& C, int l, unsigned char* shm, int sub) {
    const int G = gridDim.x;
    if (sub & 1) for (int u = blockIdx.x; u < 256; u += G) {
        const int bh = (u & 7) * 4 + (u >> 6), jp = (u >> 3) & 7;
#ifndef NO_MAIN
        attn_main_unit(C, bh >> 3, bh & 7, 15 - jp, shm);
        attn_main_unit(C, bh >> 3, bh & 7, jp, shm);
#endif
    }
#ifndef NO_SKINNY
    if (sub & 2) for (int u = blockIdx.x; u < 288; u += G) {
        if (u < 256) {
            const int b = u >> 3, h = u & 7;
            attn_skinny_unit(C, C.in[2] + ((size_t)l * 32 + b) * 1024 * 512, C.in[3] + ((size_t)l * 32 + b) * 1024 * 512,
                             C.out + OFF_KS + ((size_t)l * NSR + 16 * b) * 512, C.out + OFF_VS + ((size_t)l * NSR + 16 * b) * 512, 1024, 1040, 1024, (size_t)NPR + 16 * b, h, shm);
        } else {
            const int b = (u - 256) >> 3, h = u & 7;
            const float* kp = C.out + OFF_KP + ((size_t)l * NPR + (size_t)b * TP) * 512; const float* vp = C.out + OFF_VP + ((size_t)l * NPR + (size_t)b * TP) * 512;
            attn_skinny_unit(C, kp, vp, kp, vp, 0, 16, 0, (size_t)b * TP, h, shm);
        }
    }
#endif
    if (sub & 4) {
        const int tid = opaque_tid(), lane = tid & 63, gw = blockIdx.x * 8 + __builtin_amdgcn_readfirstlane(tid >> 6), NGW = G * 8;
#ifndef NO_POOL
        for (int u = gw; u < 4240; u += NGW) {
            const int ch = u >> 2, g = u & 3; float* PL = (float*)shm + (tid >> 6) * 1024;
            if (ch >= 1028) poolconv_wave<2>(C, l, ch, g, lane, PL);
            else if (ch % 257 == 0) poolconv_wave<1>(C, l, ch, g, lane, PL);
            else poolconv_wave<0>(C, l, ch, g, lane, PL);
        }
#endif
    }
}

#define XB_TMO      128
#define XB_XCNT(j)  (256  + 64 * (j))
#define XB_XSUB(j)  (1280 + 64 * (j))
#define XB_XGEN(j)  (2304 + 64 * (j))
#define XB_TOP      3328
#define XB_TOPGEN   3392
#define XCD_BAR_WORDS 3456
#define XB_SPIN_CAP (1u << 18)
__device__ __forceinline__ unsigned xb_ld(unsigned* p)              { return __hip_atomic_load(p, __ATOMIC_RELAXED, __HIP_MEMORY_SCOPE_AGENT); }
__device__ __forceinline__ unsigned xb_add(unsigned* p, unsigned v) { return __hip_atomic_fetch_add(p, v, __ATOMIC_RELAXED, __HIP_MEMORY_SCOPE_AGENT); }
__device__ __forceinline__ unsigned xb_xcc_id() { return (unsigned)__builtin_amdgcn_s_getreg((3 << 11) | 20) & 0xFu; }
#define XB_SPIN(cond, bar) do { unsigned _sp = 0; while (cond) { __builtin_amdgcn_s_sleep(1); \
    if ((++_sp & 255u) == 0u) { if (xb_ld(&(bar)[XB_TMO])) break; if (_sp > XB_SPIN_CAP) { atomicAdd(&(bar)[XB_TMO], 1u); break; } } } } while (0)
struct XcdBarrier { unsigned* bar; unsigned x; volatile LAS unsigned* st; };
__device__ __forceinline__ XcdBarrier xcd_barrier_post(unsigned* bar, volatile LAS unsigned* st) {
    XcdBarrier b; b.bar = bar; b.x = xb_xcc_id(); b.st = st;
    if (threadIdx.x == 0) (void)xb_add(&bar[XB_XCNT(b.x)], 1u);
    return b;
}
__device__ __forceinline__ void xcd_barrier_complete(unsigned* bar, unsigned x, unsigned& nloc, unsigned& nx) {
    const unsigned G = gridDim.x * gridDim.y * gridDim.z;
    unsigned sum, cnt, mine, sp = 0u;
    for (;;) {
        sum = 0u; cnt = 0u; mine = 0u;
#pragma unroll
        for (unsigned j = 0; j < 16; ++j) { const unsigned c = xb_ld(&bar[XB_XCNT(j)]); sum += c; cnt += (c > 0u) ? 1u : 0u; mine = (j == x) ? c : mine; }
        if (sum == G) break;
        __builtin_amdgcn_s_sleep(1);
        if ((++sp & 255u) == 0u) { if (xb_ld(&bar[XB_TMO])) break; if (sp > XB_SPIN_CAP) { atomicAdd(&bar[XB_TMO], 1u); break; } }
    }
    nloc = mine > 0u ? mine : 1u; nx = cnt > 0u ? cnt : 1u;
}
__device__ __forceinline__ void xcd_barrier(const XcdBarrier& b) {
    asm volatile("s_waitcnt vmcnt(0)" ::: "memory");
    __syncthreads();
    if (threadIdx.x == 0) {
        unsigned* bar = b.bar;
        __builtin_amdgcn_s_waitcnt(0);
        unsigned nloc = b.st[0], nx = b.st[1];
        if (nloc == 0u) { xcd_barrier_complete(bar, b.x, nloc, nx); b.st[0] = nloc; b.st[1] = nx; }
        const unsigned old = xb_add(&bar[XB_XSUB(b.x)], 1u);
        const unsigned gen = old / nloc;
        if (old + 1u == (gen + 1u) * nloc) {
            __builtin_amdgcn_fence(__ATOMIC_RELEASE, "agent");
            asm volatile("s_waitcnt vmcnt(0)" ::: "memory");
            const unsigned og = xb_add(&bar[XB_TOP], 1u);
            const unsigned tg = og / nx;
            if (og + 1u == (tg + 1u) * nx) xb_add(&bar[XB_TOPGEN], 1u);
            else XB_SPIN(xb_ld(&bar[XB_TOPGEN]) == tg, bar);
            __builtin_amdgcn_fence(__ATOMIC_ACQUIRE, "agent");
            xb_add(&bar[XB_XGEN(b.x)], 1u);
            asm volatile("s_waitcnt vmcnt(0)" ::: "memory");
        } else {
            XB_SPIN(xb_ld(&bar[XB_XGEN(b.x)]) == gen, bar);
            __builtin_amdgcn_fence(__ATOMIC_ACQUIRE, "agent");
            asm volatile("s_waitcnt vmcnt(0)" ::: "memory");
        }
    }
    __syncthreads();
}

__global__ void __launch_bounds__(512, 2) mk_fwd(Args args) {
    extern __shared__ __attribute__((aligned(16))) unsigned char shm[];
    Ctx C;
    C.in = args.in; C.out = args.out; C.ws = args.ws;
    C.RSS = (float*)(args.ws + WS_RSS); C.XB = (bf16_t*)(args.ws + WS_XB); C.HF = (float*)(args.ws + WS_HF); C.ACT = (bf16_t*)(args.ws + WS_ACT); C.G = (bf16_t*)(args.ws + WS_G);
    C.PA = (float*)(args.ws + WS_PA); C.PAB = (bf16_t*)(args.ws + WS_PA); C.MIXF = (float*)(args.ws + WS_MIXF); C.MIXB = (bf16_t*)(args.ws + WS_MIXB); C.Q = (bf16_t*)(args.ws + WS_Q); C.KP = (bf16_t*)(args.ws + WS_KP) + 48 * 512; C.VT = (bf16_t*)(args.ws + WS_VT); C.VB = (bf16_t*)(args.ws + WS_VT) + 48 * 512; C.PRE = (bf16_t*)(args.ws + WS_PRE);
    volatile LAS unsigned* bst = (volatile LAS unsigned*)((LAS unsigned char*)shm + LDS_CTL);
    if (threadIdx.x < 4) bst[threadIdx.x] = 0u;
    __syncthreads();
    XcdBarrier bar; bar.bar = (unsigned*)(args.ws + WS_BAR); bar.x = 0; bar.st = bst;
    if (args.ph_hi - args.ph_lo > 1) bar = xcd_barrier_post((unsigned*)(args.ws + WS_BAR), bst);
    for (int ph = args.ph_lo; ph < args.ph_hi; ++ph) {
      for (int rep = 0; rep < ((ph == REP_PH) ? 2 : 1); ++rep) {
#ifndef NO_PRO
        if (ph == 0) prologue_phase(C, shm);
#else
        if (ph == 0) {}
#endif
        else {
            const int l = __builtin_amdgcn_readfirstlane((ph - 1) >> 3), s = __builtin_amdgcn_readfirstlane((ph - 1) & 7);
#ifndef NO_MIX
            if (s == 3) mixers_phase(C, l, shm, rep ? REP_SUB : 7);
#else
            if (s == 3) {}
#endif
            else {
                unsigned char* wl = args.ws + WS_W + (size_t)l * W_LAYER;
                pg8::Gemm g; pg8::Sched S; pg8::EpiDesc E;
                S.nM = MP / 256; S.G = gridDim.x; S.c = blockIdx.x; S.segs = 1;
                E.l = l; E.final_ = 0; E.alpha = 1.f; E.rss_in = C.RSS; E.rss_out = C.RSS;
                if (s == 0 || s == 6) { g.A = C.XB; g.lda = DM; g.Bt = (const bf16_t*)(wl + (s == 0 ? W_GU1 : W_GU2)); g.ldb = DM; S.nN = NIN / 256; S.nt_full = DM / 64; E.kind = pg8::EK_SWIGLU; E.rss_in = C.RSS + (size_t)(3 * l + (s == 0 ? 0 : 2)) * MP; }
                else if (s == 1 || s == 7) { g.A = C.ACT; g.lda = DFF; g.Bt = (const bf16_t*)(wl + (s == 1 ? W_DN1 : W_DN2)); g.ldb = DFF; S.nN = 4; S.nt_full = DFF / 64; E.kind = pg8::EK_RESID; E.alpha = 0.5f; E.rss_out = C.RSS + (size_t)(3 * l + (s == 1 ? 1 : 3)) * MP; E.final_ = (s == 7 && l == 1); }
                else if (s == 2) { g.A = C.XB; g.lda = DM; g.Bt = (const bf16_t*)(wl + W_IN); g.ldb = DM; S.nN = NIN / 256; S.nt_full = DM / 64; E.kind = pg8::EK_PROJ; E.rss_in = C.RSS + (size_t)(3 * l + 1) * MP; }
                else if (s == 4) { g.A = C.PRE; g.lda = DM; g.Bt = (const bf16_t*)(wl + W_BR); g.ldb = DM; S.nN = 4; S.nt_full = 0; S.segs = 3; E.kind = pg8::EK_BRANCH; }
                else { g.A = C.MIXB; g.lda = DM; g.Bt = (const bf16_t*)(wl + W_OUT); g.ldb = DM; S.nN = 4; S.nt_full = DM / 64; E.kind = pg8::EK_RESID; E.alpha = 1.f; E.rss_out = C.RSS + (size_t)(3 * l + 2) * MP; }
                if (S.nN == 4) S.nM = 64;
                S.nwg = S.nM * S.nN;
#ifndef NO_GEMM
                if (PERM_MASK == 0) pg8::gemm_phase<false>((LAS unsigned char*)shm, g, S, E, C);
                else if (PERM_MASK == 15) pg8::gemm_phase<true>((LAS unsigned char*)shm, g, S, E, C);
                else if ((PERM_MASK >> E.kind) & 1) pg8::gemm_phase<true>((LAS unsigned char*)shm, g, S, E, C);
                else pg8::gemm_phase<false>((LAS unsigned char*)shm, g, S, E, C);
                if (S.nN == 4) for (int su = blockIdx.x; su < 144; su += gridDim.x) pg8::small_unit(g, E, C, su, shm);
                if (S.nN == 4 && l == 0 && gridDim.x > 160 && blockIdx.x >= 144) {
                    const int part = (s == 1) ? 0 : (s == 4) ? 1 : (s == 5) ? 2 : 3;
                    const int lo = I_LAYER + (I_LAYER * part) / 4, hi = I_LAYER + (I_LAYER * (part + 1)) / 4;
                    convert_items(C, shm, lo, hi, (blockIdx.x - 144) * 8 + (threadIdx.x >> 6), (gridDim.x - 144) * 8);
                }
#endif
            }
        }
      }
        if (ph + 1 < args.ph_hi) { if (args.ph_hi > 1000) cg::this_grid().sync(); else xcd_barrier(bar); }
    }
}

extern "C" void kernel_launch(void* const* d_in, const int* in_sizes, int n_in, void* d_out, int out_size, void* d_ws, size_t ws_size, hipStream_t stream) {
    static int grid = 0;
    if (grid == 0) {
        if (n_in != 26 || (size_t)out_size != OUT_TOTAL || ws_size < WS_END) { fprintf(stderr, "kernel_launch: unexpected shapes: n_in %d out %d ws %zu (need %zu)\n", n_in, out_size, ws_size, (size_t)WS_END); grid = -1; return; }
        int dev = 0, cus = 0, per_cu = 0;
        hipGetDevice(&dev); hipDeviceGetAttribute(&cus, hipDeviceAttributeMultiprocessorCount, dev);
        if (hipFuncSetAttribute((const void*)mk_fwd, hipFuncAttributeMaxDynamicSharedMemorySize, LDS_BYTES) != hipSuccess) { fprintf(stderr, "kernel_launch: hipFuncSetAttribute failed\n"); grid = -1; return; }
        if (hipOccupancyMaxActiveBlocksPerMultiprocessor(&per_cu, (const void*)mk_fwd, 512, LDS_BYTES) != hipSuccess || per_cu < 1) { fprintf(stderr, "kernel_launch: occupancy query says %d\n", per_cu); per_cu = 1; }
        (void)hipGetLastError();
        grid = cus * per_cu;
    }
    if (grid < 0) return;
    Args a{};
    for (int i = 0; i < 26; ++i) a.in[i] = (const float*)d_in[i];
    a.out = (float*)d_out; a.ws = (unsigned char*)d_ws;
#if MK_ONE_LAUNCH
    if (hipMemsetAsync((unsigned char*)d_ws + WS_BAR, 0, XCD_BAR_WORDS * 4, stream) != hipSuccess) { fprintf(stderr, "memset failed\n"); return; }
    a.ph_lo = 0; a.ph_hi = 17;
    void* kargs[] = {&a};
    hipError_t e = hipLaunchCooperativeKernel((const void*)mk_fwd, dim3(grid), dim3(512), kargs, LDS_BYTES, stream);
    if (e != hipSuccess) fprintf(stderr, "cooperative launch failed: %s (grid %d)\n", hipGetErrorString(e), grid);
#else
    for (int ph = 0; ph < 17; ++ph) { a.ph_lo = ph; a.ph_hi = ph + 1; hipLaunchKernelGGL(mk_fwd, dim3(grid), dim3(512), LDS_BYTES, stream, a); }
#endif
}
```
